# Optimizing an MI355X kernel written in HIP

```python
import jax, jax.numpy as jnp
from jax import lax
import numpy as np

D_MODEL = 1024
BATCH = 16
SEQ = 256
DEPTH = 1
DEC_BATCH = 8
DEC_SEQ = 1024
PAST_LEN = 256

GRID_W = 64
HEAD_DIM = 64
ATTN_DIM = D_MODEL // 2
N_HEADS = ATTN_DIM // HEAD_DIM
N_KV = 2
KV_GROUP = N_HEADS // N_KV
KV_DIM = N_KV * HEAD_DIM
CONV_DIM = D_MODEL - ATTN_DIM
CONV_WIDTH = 3
D_FF = -(-(8 * D_MODEL) // (3 * 256)) * 256
IN_DIM = ATTN_DIM + 2 * KV_DIM + 3 * CONV_DIM
ROT_PAIRS = HEAD_DIM // 4
ROPE_THETA = 10000.0
Q_BLOCK = 128
RMS_EPS = 1e-6

kernel_name = "hymba_diffusion_prefix_step"


def _rms(x, g):
    xf = x.astype(jnp.float32)
    y = xf * lax.rsqrt(jnp.mean(xf * xf, axis=-1, keepdims=True) + RMS_EPS)
    return (y * g.astype(jnp.float32)).astype(x.dtype)


def _axial_rope_tables(n_tokens, dtype):
    rows = n_tokens // GRID_W
    row = jnp.repeat(jnp.arange(rows, dtype=jnp.float32), GRID_W)
    col = jnp.tile(jnp.arange(GRID_W, dtype=jnp.float32), rows)
    inv = 1.0 / (ROPE_THETA ** (jnp.arange(ROT_PAIRS, dtype=jnp.float32) / ROT_PAIRS))
    ang = jnp.stack([row[:, None] * inv, col[:, None] * inv], axis=1)
    return jnp.cos(ang).astype(dtype), jnp.sin(ang).astype(dtype)


def _apply_rope(x, cos, sin):
    b, s, h, _ = x.shape
    xr = x.reshape(b, s, h, 2, 2, ROT_PAIRS)
    x1, x2 = xr[..., 0, :], xr[..., 1, :]
    c = cos[None, :, None]
    sn = sin[None, :, None]
    out = jnp.stack([x1 * c - x2 * sn, x1 * sn + x2 * c], axis=-2)
    return out.reshape(b, s, h, HEAD_DIM)


def _block_attention(q, k, v):
    b, s = q.shape[:2]
    nb = s // Q_BLOCK
    qb = q.reshape(b, nb, Q_BLOCK, N_KV, KV_GROUP, HEAD_DIM).transpose(1, 0, 2, 3, 4, 5)
    scale = HEAD_DIM ** -0.5

    def one_block(qblk):
        sc = jnp.einsum("bqkgd,btkd->bkgqt", qblk, k).astype(jnp.float32) * scale
        p = jax.nn.softmax(sc, axis=-1).astype(v.dtype)
        return jnp.einsum("bkgqt,btkd->bqkgd", p, v)

    out = lax.map(one_block, qb)
    return out.transpose(1, 0, 2, 3, 4, 5).reshape(b, s, ATTN_DIM)


def _short_conv(u, w):
    up = jnp.pad(u, ((0, 0), (1, 1), (0, 0)))
    return w[0] * up[:, :-2] + w[1] * up[:, 1:-1] + w[2] * up[:, 2:]


def _mixer(h, rope, ctx_k, ctx_v, w_in, q_norm, k_norm, conv_w, attn_out_norm, conv_out_norm, w_out):
    b, s, _ = h.shape
    proj = h @ w_in
    q, k, v, gb, gc, u = jnp.split(
        proj, np.cumsum([ATTN_DIM, KV_DIM, KV_DIM, CONV_DIM, CONV_DIM]).tolist(), axis=-1)
    q = _rms(q.reshape(b, s, N_HEADS, HEAD_DIM), q_norm)
    k = _rms(k.reshape(b, s, N_KV, HEAD_DIM), k_norm)
    v = v.reshape(b, s, N_KV, HEAD_DIM)
    if rope is None:
        attn = _block_attention(q, k, v)
    else:
        cos, sin = rope
        q_r = _apply_rope(q, cos, sin)
        k_r = _apply_rope(k, cos, sin)
        k_all = jnp.concatenate([ctx_k, k_r], axis=1)
        v_all = jnp.concatenate([ctx_v, v], axis=1)
        attn = _block_attention(q_r, k_all, v_all)
    y_conv = gb * _short_conv(gc * u, conv_w)
    merged = jnp.concatenate([_rms(attn, attn_out_norm), _rms(y_conv, conv_out_norm)], axis=-1)
    return merged @ w_out, k, v


def _layer(x, cond, rope, ctx_k, ctx_v, norm_mix, norm_ffn, w_ada, b_ada, w_in, q_norm, k_norm,
           conv_w, attn_out_norm, conv_out_norm, w_out, w_gate_up, w_down):
    mod = (jax.nn.silu(cond) @ w_ada + b_ada)[:, None, :]
    sh1, sc1, g1, sh2, sc2, g2 = jnp.split(mod, 6, axis=-1)
    h = _rms(x, norm_mix) * (1 + sc1) + sh1
    mix, k, v = _mixer(h, rope, ctx_k, ctx_v, w_in, q_norm, k_norm, conv_w,
                       attn_out_norm, conv_out_norm, w_out)
    x = x + g1 * mix
    h2 = _rms(x, norm_ffn) * (1 + sc2) + sh2
    gate, up = jnp.split(h2 @ w_gate_up, 2, axis=-1)
    x = x + g2 * ((jax.nn.silu(gate) * up) @ w_down)
    return x, k, v


def setup_inputs(seed: int = 0) -> dict:
    key = jax.random.key(seed)
    ks = jax.random.split(key, 20)
    f = jnp.float32
    nrm = lambda k, shape, s: jax.random.normal(k, shape, f) * s
    return {
        "x_prompt": nrm(ks[0], (BATCH, SEQ, D_MODEL), 1.0),
        "x_sample": nrm(ks[1], (DEC_BATCH, DEC_SEQ, D_MODEL), 1.0),
        "c": nrm(ks[2], (DEC_BATCH, D_MODEL), 1.0),
        "cache_k": nrm(ks[3], (DEC_BATCH, DEPTH, PAST_LEN, N_KV, HEAD_DIM), 1.0),
        "cache_v": nrm(ks[4], (DEC_BATCH, DEPTH, PAST_LEN, N_KV, HEAD_DIM), 1.0),
        "c_ctx": nrm(ks[5], (D_MODEL,), 1.0),
        "norm_mix": 1.0 + nrm(ks[6], (DEPTH, D_MODEL), 0.02),
        "norm_ffn": 1.0 + nrm(ks[7], (DEPTH, D_MODEL), 0.02),
        "w_ada": nrm(ks[8], (DEPTH, D_MODEL, 6 * D_MODEL), 0.5 * D_MODEL ** -0.5),
        "b_ada": nrm(ks[9], (DEPTH, 6 * D_MODEL), 0.02),
        "w_in": nrm(ks[10], (DEPTH, D_MODEL, IN_DIM), D_MODEL ** -0.5),
        "q_norm": 1.0 + nrm(ks[11], (DEPTH, HEAD_DIM), 0.02),
        "k_norm": 1.0 + nrm(ks[12], (DEPTH, HEAD_DIM), 0.02),
        "conv_w": nrm(ks[13], (DEPTH, CONV_WIDTH, CONV_DIM), CONV_WIDTH ** -0.5),
        "attn_out_norm": 1.0 + nrm(ks[14], (DEPTH, ATTN_DIM), 0.02),
        "conv_out_norm": 1.0 + nrm(ks[15], (DEPTH, CONV_DIM), 0.02),
        "w_out": nrm(ks[16], (DEPTH, D_MODEL, D_MODEL), D_MODEL ** -0.5),
        "w_gate_up": nrm(ks[17], (DEPTH, D_MODEL, 2 * D_FF), D_MODEL ** -0.5),
        "w_down": nrm(ks[18], (DEPTH, D_FF, D_MODEL), D_FF ** -0.5),
    }


def reference(x_prompt, x_sample, c, cache_k, cache_v, c_ctx, norm_mix, norm_ffn, w_ada, b_ada,
              w_in, q_norm, k_norm, conv_w, attn_out_norm, conv_out_norm, w_out, w_gate_up, w_down):
    rope = _axial_rope_tables(x_sample.shape[1], x_sample.dtype)
    cond_ctx = c_ctx[None, :]
    xp = x_prompt
    xs = x_sample
    new_k, new_v = [], []
    for l in range(DEPTH):
        params = (norm_mix[l], norm_ffn[l], w_ada[l], b_ada[l], w_in[l], q_norm[l], k_norm[l],
                  conv_w[l], attn_out_norm[l], conv_out_norm[l], w_out[l], w_gate_up[l], w_down[l])
        xp, k_l, v_l = _layer(xp, cond_ctx, None, None, None, *params)
        new_k.append(k_l)
        new_v.append(v_l)
        xs, _, _ = _layer(xs, c, rope, cache_k[:, l], cache_v[:, l], *params)
    ctx_k = jnp.stack(new_k, axis=1)
    ctx_v = jnp.stack(new_v, axis=1)
    return (xp, xs, ctx_k, ctx_v)
```

```cpp
#include <hip/hip_runtime.h>
#include <hip/hip_cooperative_groups.h>
#include <cstdio>
#include <cstdint>
namespace cg = cooperative_groups;
#ifndef PROBE_DUP
#define PROBE_DUP -1
#endif
namespace pg8 {
#define PG8_LAS __attribute__((address_space(3)))
typedef unsigned short bf16_t;
typedef short bf16x8 __attribute__((ext_vector_type(8)));
typedef float f32x4 __attribute__((ext_vector_type(4)));
typedef unsigned u32x4 __attribute__((ext_vector_type(4)));
constexpr int BM = 256, BK = 64, HALF = 128, HTB = HALF * BK * 2  , STAGE_BYTES = 8 * HTB, NXCD = 8, WGM = 8;

__host__ __device__ __forceinline__ int lds_byte(int r, int c) { const int st = (r >> 4) * 2 + (c >> 5), rr = r & 15, cc = c & 31, ob = rr * 64 + cc * 2; return st * 1024 + (ob ^ (((ob >> 9) & 1) << 5)); }
__host__ __device__ __forceinline__ void stage_rc(int b, int& R, int& C) { const int st = b / 1024, sb = b % 1024, swz = sb ^ (((sb >> 9) & 1) << 5); R = (st >> 1) * 16 + swz / 64; C = (st & 1) * 32 + (swz % 64) / 2; }
__host__ __device__ __forceinline__ int perm32(int rho) { const int n = rho >> 4, i = rho & 15; return 8 * (i >> 2) + 4 * n + (i & 3); }

struct Unit { int pm, pn; };
struct Gemm { const bf16_t* A; const bf16_t* Bt; int M, N, K; };

struct StaticOrder {
    int nM, nN, nwg, G, c;
    __host__ __device__ void init(int M, int N, int G_, int c_, int bm = BM) { nM = M / bm; nN = N / BM; nwg = nM * nN; G = G_; c = c_; }
    __host__ __device__ bool next(int i, Unit& u) const {
        const long L = (long)i * G + c; if (L >= nwg) return false;
        int wgid = (int)L; { const int q = nwg / NXCD, r = nwg % NXCD, xcd = wgid % NXCD, off = wgid / NXCD; wgid = (xcd < r ? xcd * (q + 1) : r * (q + 1) + (xcd - r) * q) + off; }
        const int nig = WGM * nN, gid = wgid / nig, fm = gid * WGM, gsz = (nM - fm) < WGM ? (nM - fm) : WGM;
        u.pm = fm + ((wgid % nig) % gsz); u.pn = (wgid % nig) / gsz; return true;
    }
    __device__ __forceinline__ void a_ready(const Unit&) const {}
    __device__ __forceinline__ void done(const Unit&) const {}
};
typedef float f32x2cv_t __attribute__((ext_vector_type(2))); typedef __bf16 bf16x2cv_t __attribute__((ext_vector_type(2)));
__device__ __forceinline__ unsigned cvt_pk_bf16(float lo, float hi) { f32x2cv_t v = {lo, hi}; bf16x2cv_t b = __builtin_convertvector(v, bf16x2cv_t); return __builtin_bit_cast(unsigned, b); }
typedef float f32x2 __attribute__((ext_vector_type(2)));
template <class Epi, class Sched, bool ALIGN_EPI = false, bool SP2 = false>
__device__ __forceinline__ void gemm_phase(PG8_LAS unsigned char* lds, const Gemm g, const Sched& S, const Epi& E) {
    const int tid = threadIdx.x, wid = __builtin_amdgcn_readfirstlane(tid >> 6), lane = tid & 63, wr = wid >> 2, wc = wid & 3, fr = lane & 15, fq = lane >> 4;
    const int K = g.K, nt = K / BK;
    unsigned voffA[2], voffB[2];
#pragma unroll
    for (int i = 0; i < 2; ++i) { int R, C; stage_rc(tid * 16 + i * 8192, R, C); const int Rb = Epi::PERM ? ((R & ~31) + perm32(R & 31)) : R;
        voffA[i] = (unsigned)(R * K + C) * 2u; voffB[i] = (unsigned)(Rb * K + C) * 2u; }
    const size_t kstep = (size_t)(BK * 2);
    constexpr int MT = Epi::MT, HA = 32 * MT;
    const size_t hstepA = (size_t)HA * K * 2, hstep = (size_t)HALF * K * 2;
    const size_t tstepA = 2 * hstepA, tstep = 2 * hstep;
    const unsigned ldsw = (unsigned)wid * 1024u;
    const int aoff = lds_byte(wr * (16 * MT) + fr, fq * 8), boff = lds_byte(wc * 32 + fr, fq * 8);
#define PG8_SA(b, h) (((b) * 2 + (h)) * HTB)
#define PG8_SB(b, h) ((4 + (b) * 2 + (h)) * HTB)
#define PG8_STAGE(bufoff, gbase, voff) do { _Pragma("unroll") for (int _i = 0; _i < 2; ++_i) \
        __builtin_amdgcn_global_load_lds((const unsigned*)((const char*)(gbase) + (voff)[_i]), (PG8_LAS unsigned*)(lds + (bufoff) + ldsw + _i * 8192), 16, 0, 0); } while (0)
#define PG8_LDA(dst, b, h) do { _Pragma("unroll") for (int m = 0; m < MT; ++m) _Pragma("unroll") for (int k = 0; k < 2; ++k) dst[m][k] = *(const PG8_LAS bf16x8*)(lds + PG8_SA(b, h) + aoff + m * 2048 + k * 1024); } while (0)
#define PG8_LDB(dst, b, h) do { _Pragma("unroll") for (int n = 0; n < 2; ++n) _Pragma("unroll") for (int k = 0; k < 2; ++k) dst[n][k] = *(const PG8_LAS bf16x8*)(lds + PG8_SB(b, h) + boff + n * 2048 + k * 1024); } while (0)
#define PG8_MMA(ai, bj, At, Bt) do { __builtin_amdgcn_s_setprio(1); _Pragma("unroll") for (int m = 0; m < MT; ++m) _Pragma("unroll") for (int n = 0; n < 2; ++n) _Pragma("unroll") for (int k = 0; k < 2; ++k) \
        acc[ai][bj][m][n] = __builtin_amdgcn_mfma_f32_16x16x32_bf16(Bt[n][k], At[m][k], acc[ai][bj][m][n], 0, 0, 0); __builtin_amdgcn_s_setprio(0); } while (0)
#define PG8_WAIT_V(n) asm volatile("s_waitcnt vmcnt(" #n ")" ::: "memory")
#define PG8_WAIT_L(n) asm volatile("s_waitcnt lgkmcnt(" #n ")" ::: "memory")
#define PG8_BAR __builtin_amdgcn_s_barrier()
#define PG8_SCHED __builtin_amdgcn_sched_barrier(0)
    Unit cur, nxt; int ui = 0;
    if (!S.next(0, cur)) return;
    f32x4 acc[2][2][MT][2];
#pragma unroll
    for (int a = 0; a < 2; ++a)
#pragma unroll
        for (int b = 0; b < 2; ++b)
#pragma unroll
            for (int m = 0; m < MT; ++m)
#pragma unroll
                for (int n = 0; n < 2; ++n) acc[a][b][m][n] = (f32x4){0.f, 0.f, 0.f, 0.f};
    bf16x8 At[MT][2], B0[2][2], B1[2][2];
    const char* cA = (const char*)g.A + (size_t)cur.pm * tstepA; const char* cB = (const char*)g.Bt + (size_t)cur.pn * tstep;
    S.a_ready(cur);
    if constexpr (SP2) {
        PG8_STAGE(PG8_SB(0, 0), cB, voffB); PG8_STAGE(PG8_SB(0, 1), cB + hstep, voffB); PG8_STAGE(PG8_SA(0, 0), cA, voffA); PG8_STAGE(PG8_SA(0, 1), cA + hstepA, voffA);
        if (wr == 1) PG8_BAR;
        PG8_WAIT_V(2); PG8_BAR;
        PG8_STAGE(PG8_SB(1, 0), cB + kstep, voffB); PG8_STAGE(PG8_SA(1, 0), cA + kstep, voffA); PG8_STAGE(PG8_SB(1, 1), cB + hstep + kstep, voffB);
        PG8_WAIT_V(6); PG8_BAR;
    } else {
        PG8_STAGE(PG8_SB(0, 0), cB, voffB); PG8_STAGE(PG8_SA(0, 0), cA, voffA); PG8_STAGE(PG8_SB(0, 1), cB + hstep, voffB); PG8_STAGE(PG8_SA(0, 1), cA + hstepA, voffA);
        if (wr == 1) PG8_BAR;
        PG8_WAIT_V(4); PG8_BAR;
        PG8_STAGE(PG8_SB(1, 0), cB + kstep, voffB); PG8_STAGE(PG8_SA(1, 0), cA + kstep, voffA); PG8_STAGE(PG8_SB(1, 1), cB + hstep + kstep, voffB);
        PG8_WAIT_V(6); PG8_BAR;
    }
    for (;;) {
        const bool has_next = S.next(ui + 1, nxt);
        const char* nA = has_next ? (const char*)g.A + (size_t)nxt.pm * tstepA : cA; const char* nB = has_next ? (const char*)g.Bt + (size_t)nxt.pn * tstep : cB;
        for (int t = 0; t < nt; t += 2) {
            const bool last = (t == nt - 2);
            const char* a1 = cA + (size_t)(t + 1) * kstep;
            const char* a2 = last ? nA : cA + (size_t)(t + 2) * kstep; const char* b2 = last ? nB : cB + (size_t)(t + 2) * kstep;
            const char* a3 = a2 + kstep; const char* b3 = b2 + kstep;
            if (last && has_next) S.a_ready(nxt);
            if constexpr (SP2) {
            PG8_LDB(B0, 0, 0); PG8_LDB(B1, 0, 1); PG8_SCHED; PG8_LDA(At, 0, 0); PG8_STAGE(PG8_SA(1, 1), a1 + hstepA, voffA);
            PG8_WAIT_V(8); PG8_WAIT_L(0); PG8_BAR; PG8_MMA(0, 0, At, B0); PG8_MMA(0, 1, At, B1); PG8_BAR; PG8_SCHED;
            PG8_LDA(At, 0, 1); PG8_STAGE(PG8_SB(0, 0), b2, voffB); PG8_STAGE(PG8_SB(0, 1), b2 + hstep, voffB); PG8_STAGE(PG8_SA(0, 0), a2, voffA);
            PG8_WAIT_V(8); PG8_WAIT_L(0); PG8_BAR; PG8_MMA(1, 0, At, B0); PG8_MMA(1, 1, At, B1); PG8_BAR; PG8_SCHED;
            PG8_LDB(B0, 1, 0); PG8_LDB(B1, 1, 1); PG8_SCHED; PG8_LDA(At, 1, 0); PG8_STAGE(PG8_SA(0, 1), a2 + hstepA, voffA);
            PG8_WAIT_V(8); PG8_WAIT_L(0); PG8_BAR; PG8_MMA(0, 0, At, B0); PG8_MMA(0, 1, At, B1); PG8_BAR; PG8_SCHED;
            PG8_LDA(At, 1, 1); PG8_STAGE(PG8_SB(1, 0), b3, voffB); PG8_STAGE(PG8_SB(1, 1), b3 + hstep, voffB); PG8_STAGE(PG8_SA(1, 0), a3, voffA);
            PG8_WAIT_V(8); PG8_WAIT_L(0); PG8_BAR; PG8_MMA(1, 0, At, B0); PG8_MMA(1, 1, At, B1); PG8_BAR; PG8_SCHED;
            } else {
            PG8_LDB(B0, 0, 0); PG8_SCHED; PG8_LDA(At, 0, 0); PG8_STAGE(PG8_SA(1, 1), a1 + hstepA, voffA);
            PG8_WAIT_L(8); PG8_BAR; PG8_WAIT_L(0); PG8_MMA(0, 0, At, B0); PG8_BAR; PG8_SCHED;
            PG8_LDB(B1, 0, 1); PG8_STAGE(PG8_SB(0, 0), b2, voffB);
            PG8_BAR; PG8_WAIT_L(0); PG8_MMA(0, 1, At, B1); PG8_BAR;
            PG8_LDA(At, 0, 1); PG8_STAGE(PG8_SA(0, 0), a2, voffA);
            PG8_BAR; PG8_WAIT_L(0); PG8_MMA(1, 0, At, B0); PG8_BAR; PG8_SCHED;
            PG8_STAGE(PG8_SB(0, 1), b2 + hstep, voffB);
            PG8_WAIT_V(6); PG8_BAR; PG8_MMA(1, 1, At, B1); PG8_BAR;
            PG8_LDB(B0, 1, 0); PG8_SCHED; PG8_LDA(At, 1, 0); PG8_STAGE(PG8_SA(0, 1), a2 + hstepA, voffA);
            PG8_WAIT_L(8); PG8_BAR; PG8_WAIT_L(0); PG8_MMA(0, 0, At, B0); PG8_BAR; PG8_SCHED;
            PG8_LDB(B1, 1, 1); PG8_STAGE(PG8_SB(1, 0), b3, voffB);
            PG8_BAR; PG8_WAIT_L(0); PG8_MMA(0, 1, At, B1); PG8_BAR;
            PG8_LDA(At, 1, 1); PG8_STAGE(PG8_SA(1, 0), a3, voffA);
            PG8_BAR; PG8_WAIT_L(0); PG8_MMA(1, 0, At, B0); PG8_BAR; PG8_SCHED;
            PG8_STAGE(PG8_SB(1, 1), b3 + hstep, voffB);
            PG8_WAIT_V(6); PG8_BAR; PG8_MMA(1, 1, At, B1); PG8_BAR;
            }
        }
        if constexpr (ALIGN_EPI) { if (wr == 0) PG8_BAR; }
        if constexpr (!Epi::AFTER_DRAIN) { E(acc, cur, wr, wc, fr, fq); S.done(cur); }
        if (!has_next) break;
#pragma unroll
        for (int a = 0; a < 2; ++a)
#pragma unroll
            for (int b = 0; b < 2; ++b)
#pragma unroll
                for (int m = 0; m < MT; ++m)
#pragma unroll
                    for (int n = 0; n < 2; ++n) acc[a][b][m][n] = (f32x4){0.f, 0.f, 0.f, 0.f};
        cur = nxt; cA = nA; cB = nB; ++ui;
        if constexpr (ALIGN_EPI) { if (wr == 1) PG8_BAR; }
    }
    PG8_WAIT_V(0);
    if constexpr (!ALIGN_EPI) { if (wr == 0) PG8_BAR; }
    PG8_BAR;
    if constexpr (Epi::AFTER_DRAIN) { E.fused(acc, cur, wr, wc, fr, fq, lds, wid, lane); S.done(cur); }
#undef PG8_SA
#undef PG8_SB
#undef PG8_STAGE
#undef PG8_LDA
#undef PG8_LDB
#undef PG8_MMA
#undef PG8_WAIT_V
#undef PG8_WAIT_L
#undef PG8_BAR
#undef PG8_SCHED
}
constexpr int TOK_CTX = 4096, TOK_ALL = 12288, PITCH_P = 2304;
constexpr float RMS_EPS_F = 1e-6f;
constexpr float QSCALE = 0.125f * 1.4426950408889634f;
__device__ __forceinline__ u32x4 pack8(const f32x4 a, const f32x4 b) { u32x4 w; w.x = cvt_pk_bf16(a[0], a[1]); w.y = cvt_pk_bf16(a[2], a[3]); w.z = cvt_pk_bf16(b[0], b[1]); w.w = cvt_pk_bf16(b[2], b[3]); return w; }
__device__ __forceinline__ unsigned short bf1(float f) { return (unsigned short)(cvt_pk_bf16(f, 0.f) & 0xffffu); }

struct EpiIn {
    static constexpr bool PERM = true, AFTER_DRAIN = false; static constexpr int MT = 4;
    bf16_t* P; bf16_t* Kl; bf16_t* Vl; bf16_t* Kc; bf16_t* Vc; float* newk; float* newv; const float* qn; const float* kn; const float* rope;
    __device__ __forceinline__ void operator()(const f32x4 (&acc)[2][2][4][2], const Unit& u, int wr, int wc, int fr, int fq) const {
        const int row0 = u.pm * BM + wr * 64 + fr;
        if (u.pn >= 3) {
            const int col0 = u.pn * BM + wc * 32 + 8 * fq;
#pragma unroll
            for (int ai = 0; ai < 2; ++ai)
#pragma unroll
                for (int m = 0; m < 4; ++m) { bf16_t* rowp = P + (size_t)(row0 + ai * HALF + m * 16) * PITCH_P + col0;
#pragma unroll
                    for (int bj = 0; bj < 2; ++bj) *(u32x4*)(rowp + bj * HALF) = pack8(acc[ai][bj][m][0], acc[ai][bj][m][1]); }
            return;
        }
        const int head = 4 * u.pn + wc;
        const bool lat = u.pm >= 16;
        if (head < 10) {
            const float* gsrc = head < 8 ? qn : kn;
            const float oscale = head < 8 ? QSCALE : 1.0f;
            f32x4 g[2][2];
#pragma unroll
            for (int bj = 0; bj < 2; ++bj)
#pragma unroll
                for (int n = 0; n < 2; ++n) g[bj][n] = *(const f32x4*)(gsrc + 32 * bj + 8 * fq + 4 * n);
            const float sgn = (fq & 2) ? 1.0f : -1.0f;
#pragma unroll
            for (int ai = 0; ai < 2; ++ai)
#pragma unroll
                for (int m = 0; m < 4; ++m) {
                    const int r = row0 + ai * HALF + m * 16;
                    float ss = 0.f;
#pragma unroll
                    for (int bj = 0; bj < 2; ++bj)
#pragma unroll
                        for (int n = 0; n < 2; ++n) { const f32x4 x = acc[ai][bj][m][n]; ss += (x[0] * x[0] + x[1] * x[1]) + (x[2] * x[2] + x[3] * x[3]); }
                    ss += __shfl_xor(ss, 16); ss += __shfl_xor(ss, 32);
                    const float rinv = 1.0f / sqrtf(ss * (1.0f / 64.0f) + RMS_EPS_F);
                    f32x4 v[2][2];
#pragma unroll
                    for (int bj = 0; bj < 2; ++bj)
#pragma unroll
                        for (int n = 0; n < 2; ++n) v[bj][n] = acc[ai][bj][m][n] * rinv * g[bj][n];
                    if (!lat && head >= 8) {
                        float* nk = newk + ((size_t)r * 2 + (head - 8)) * 64 + 8 * fq;
#pragma unroll
                        for (int bj = 0; bj < 2; ++bj)
#pragma unroll
                            for (int n = 0; n < 2; ++n) *(f32x4*)(nk + 32 * bj + 4 * n) = v[bj][n];
                    }
                    if (lat) {
                        const int s = (r - TOK_CTX) & 1023;
#pragma unroll
                        for (int bj = 0; bj < 2; ++bj) {
                            const int pos = bj == 0 ? (s >> 6) : (s & 63);
#pragma unroll
                            for (int n = 0; n < 2; ++n) {
                                const f32x4 cs = *(const f32x4*)(rope + pos * 16 + 8 * (fq & 1) + 4 * n);
                                const f32x4 sn = *(const f32x4*)(rope + 1024 + pos * 16 + 8 * (fq & 1) + 4 * n);
                                f32x4 pt;
#pragma unroll
                                for (int j = 0; j < 4; ++j) pt[j] = __shfl_xor(v[bj][n][j], 32);
                                v[bj][n] = v[bj][n] * cs + pt * (sn * sgn);
                            }
                        }
                    }
                    bf16_t* dst;
                    if (head < 8) dst = P + (size_t)r * PITCH_P + head * 64 + 8 * fq;
                    else if (lat) { const int b = (r - TOK_CTX) >> 10, s = (r - TOK_CTX) & 1023; dst = Kl + ((size_t)(b * 2 + (head - 8)) * 1280 + 256 + s) * 64 + 8 * fq; }
                    else { const int b = r >> 8, s = r & 255; dst = Kc + ((size_t)(b * 2 + (head - 8)) * 256 + s) * 64 + 8 * fq; }
#pragma unroll
                    for (int bj = 0; bj < 2; ++bj) *(u32x4*)(dst + 32 * bj) = pack8(v[bj][0] * oscale, v[bj][1] * oscale);
                }
        } else {
            const int kvh = head - 10;
#pragma unroll
            for (int ai = 0; ai < 2; ++ai)
#pragma unroll
                for (int m = 0; m < 4; ++m) {
                    const int r = row0 + ai * HALF + m * 16;
                    bf16_t* vt; int T;
                    if (lat) { const int b = (r - TOK_CTX) >> 10, s = (r - TOK_CTX) & 1023; T = 1280; vt = Vl + (size_t)(b * 2 + kvh) * 64 * 1280 + 256 + s; }
                    else { const int b = r >> 8, s = r & 255; T = 256; vt = Vc + (size_t)(b * 2 + kvh) * 64 * 256 + s;
                        float* nv = newv + ((size_t)r * 2 + kvh) * 64 + 8 * fq;
#pragma unroll
                        for (int bj = 0; bj < 2; ++bj)
#pragma unroll
                            for (int n = 0; n < 2; ++n) *(f32x4*)(nv + 32 * bj + 4 * n) = acc[ai][bj][m][n]; }
#pragma unroll
                    for (int bj = 0; bj < 2; ++bj)
#pragma unroll
                        for (int n = 0; n < 2; ++n)
#pragma unroll
                            for (int j = 0; j < 4; ++j) vt[(size_t)(32 * bj + 8 * fq + 4 * n + j) * T] = bf1(acc[ai][bj][m][n][j]);
                }
        }
    }
};

struct EpiRes {
    static constexpr bool PERM = false, AFTER_DRAIN = false; static constexpr int MT = 4;
    const float* xa; const float* xb; float* out; const float* gate;
    __device__ __forceinline__ void operator()(const f32x4 (&acc)[2][2][4][2], const Unit& u, int wr, int wc, int fr, int fq) const {
        const int row0 = u.pm * BM + wr * 64 + fr, col0 = u.pn * BM + wc * 32 + 4 * fq;
        const int mrow = u.pm < 16 ? 8 : ((u.pm - 16) >> 2);
        f32x4 g[2][2];
#pragma unroll
        for (int bj = 0; bj < 2; ++bj)
#pragma unroll
            for (int n = 0; n < 2; ++n) g[bj][n] = *(const f32x4*)(gate + (size_t)mrow * 6144 + col0 + bj * HALF + n * 16);
#pragma unroll
        for (int ai = 0; ai < 2; ++ai)
#pragma unroll
            for (int m = 0; m < 4; ++m) {
                const int r = row0 + ai * HALF + m * 16;
                const float* bp = (r < TOK_CTX ? xa + (size_t)r * 1024 : xb + (size_t)(r - TOK_CTX) * 1024) + col0;
                float* op = out + (size_t)r * 1024 + col0;
#pragma unroll
                for (int bj = 0; bj < 2; ++bj)
#pragma unroll
                    for (int n = 0; n < 2; ++n) { const f32x4 b = *(const f32x4*)(bp + bj * HALF + n * 16); *(f32x4*)(op + bj * HALF + n * 16) = b + g[bj][n] * acc[ai][bj][m][n]; }
            }
    }
};

struct EpiSwiGLU {
    static constexpr bool PERM = true, AFTER_DRAIN = false; static constexpr int MT = 4;
    bf16_t* act; int ldc;
    __device__ __forceinline__ void operator()(const f32x4 (&acc)[2][2][4][2], const Unit& u, int wr, int wc, int fr, int fq) const {
        const int row0 = u.pm * BM + wr * 64 + fr, col0 = u.pn * HALF + wc * 32 + 8 * fq;
#pragma unroll
        for (int ai = 0; ai < 2; ++ai)
#pragma unroll
            for (int m = 0; m < 4; ++m) {
                f32x4 o[2];
#pragma unroll
                for (int n = 0; n < 2; ++n) {
                    const f32x4 gt = acc[ai][0][m][n], up = acc[ai][1][m][n];
#pragma unroll
                    for (int j = 0; j < 4; ++j) { const float e = __builtin_amdgcn_exp2f(gt[j] * -1.4426950408889634f); o[n][j] = gt[j] * __builtin_amdgcn_rcpf(1.0f + e) * up[j]; }
                }
                *(u32x4*)(act + (size_t)(row0 + ai * HALF + m * 16) * ldc + col0) = pack8(o[0], o[1]);
            }
    }
};

struct EpiRes3 {
    static constexpr bool PERM = false, AFTER_DRAIN = false; static constexpr int MT = 3;
    const float* xa; const float* xb; float* out; const float* gate;
    __device__ __forceinline__ void operator()(const f32x4 (&acc)[2][2][3][2], const Unit& u, int wr, int wc, int fr, int fq) const {
        const int col0 = u.pn * BM + wc * 32 + 4 * fq;
#pragma unroll
        for (int ai = 0; ai < 2; ++ai)
#pragma unroll
            for (int m = 0; m < 3; ++m) {
                const int rg = u.pm * 192 + ai * 96 + wr * 48 + m * 16, r = rg + fr;
                const int mrow = rg < TOK_CTX ? 8 : ((rg - TOK_CTX) >> 10);
                const float* gp = gate + (size_t)mrow * 6144 + col0;
                const float* bp = (r < TOK_CTX ? xa + (size_t)r * 1024 : xb + (size_t)(r - TOK_CTX) * 1024) + col0;
                float* op = out + (size_t)r * 1024 + col0;
#pragma unroll
                for (int bj = 0; bj < 2; ++bj)
#pragma unroll
                    for (int n = 0; n < 2; ++n) { const f32x4 b = *(const f32x4*)(bp + bj * HALF + n * 16), g = *(const f32x4*)(gp + bj * HALF + n * 16); *(f32x4*)(op + bj * HALF + n * 16) = b + g * acc[ai][bj][m][n]; }
            }
    }
};
struct EpiSwiGLU3 {
    static constexpr bool PERM = true, AFTER_DRAIN = false; static constexpr int MT = 3;
    bf16_t* act; int ldc;
    __device__ __forceinline__ void operator()(const f32x4 (&acc)[2][2][3][2], const Unit& u, int wr, int wc, int fr, int fq) const {
        const int col0 = u.pn * HALF + wc * 32 + 8 * fq;
#pragma unroll
        for (int ai = 0; ai < 2; ++ai)
#pragma unroll
            for (int m = 0; m < 3; ++m) {
                const int r = u.pm * 192 + ai * 96 + wr * 48 + m * 16 + fr;
                f32x4 o[2];
#pragma unroll
                for (int n = 0; n < 2; ++n) {
                    const f32x4 gt = acc[ai][0][m][n], up = acc[ai][1][m][n];
#pragma unroll
                    for (int j = 0; j < 4; ++j) { const float e = __builtin_amdgcn_exp2f(gt[j] * -1.4426950408889634f); o[n][j] = gt[j] * __builtin_amdgcn_rcpf(1.0f + e) * up[j]; }
                }
                *(u32x4*)(act + (size_t)r * ldc + col0) = pack8(o[0], o[1]);
            }
    }
};
}
#define GAS __attribute__((address_space(1)))
#define LAS __attribute__((address_space(3)))
typedef unsigned short bf16;
typedef unsigned v4u __attribute__((ext_vector_type(4)));
typedef float f32x4 __attribute__((ext_vector_type(4)));
typedef float f32x16 __attribute__((ext_vector_type(16)));
typedef short bf16x8 __attribute__((ext_vector_type(8)));
constexpr int NWAVES = 8, NTHREADS = 512;
constexpr int D = 1024, M_CTX = 4096, M_ALL = 12288, IN_DIM = 2304, D_FF = 2816, NGU = 5632, MODW = 6144;
constexpr size_t MiB = 1u << 20;
constexpr size_t WS_MOD = 1 * MiB, WS_ROPE = 1 * MiB + 512 * 1024, WS_WIN = 2 * MiB, WS_WOUT = 7 * MiB, WS_WGU = 9 * MiB, WS_WDN = 20 * MiB;
constexpr size_t WS_KL = 26 * MiB, WS_VL = 29 * MiB, WS_KC = 32 * MiB, WS_VC = 33 * MiB, WS_H = 34 * MiB, WS_P = 58 * MiB, WS_MRG = 34 * MiB  , WS_ACT = 58 * MiB  , WS_END = 124 * MiB;
constexpr int RING_BYTES = 131072, LDS_BYTES = 147456;

__device__ __forceinline__ unsigned f2bf(float f) { unsigned u = __builtin_bit_cast(unsigned, f); return (u + 0x7fffu + ((u >> 16) & 1u)) >> 16; }
__device__ __forceinline__ unsigned pk2(float lo, float hi) { return f2bf(lo) | (f2bf(hi) << 16); }
__device__ __forceinline__ float bf2f(unsigned short h) { return __builtin_bit_cast(float, (unsigned)h << 16); }
__device__ __forceinline__ float wave_sum(float v) {
#pragma unroll
    for (int o = 1; o < 64; o <<= 1) v += __shfl_xor(v, o);
    return v;
}
#define LDS_WAIT() asm volatile("s_waitcnt lgkmcnt(0)" ::: "memory")

struct Args {
    const float* xp; const float* xs; const float* c; const float* cache_k; const float* cache_v; const float* c_ctx; const float* norm_mix; const float* norm_ffn;
    const float* w_ada; const float* b_ada; const float* w_in; const float* q_norm; const float* k_norm; const float* conv_w; const float* aon; const float* con;
    const float* w_out; const float* w_gu; const float* w_dn; float* out; unsigned char* ws; int ph_lo, ph_hi, li, pad;
};

__device__ __forceinline__ void transpose_item(const float* W, int ldw, int src0, int K, int k0, bf16* WT, int dst0, const float* kgain, LAS float* scr, int lane) {
#pragma unroll
    for (int i = 0; i < 32; ++i) { const int kk = 2 * i + (lane >> 5); float w = W[(size_t)(k0 + kk) * ldw + src0 + (lane & 31)]; if (kgain) w *= kgain[k0 + kk]; scr[kk * 33 + (lane & 31)] = w; }
    LDS_WAIT(); asm volatile("" ::: "memory");
    const int c = lane & 7;
#pragma unroll
    for (int j = 0; j < 4; ++j) { const int n = (lane >> 3) + 8 * j; const LAS float* s = scr + (8 * c) * 33 + n;
        v4u o; o.x = pk2(s[0 * 33], s[1 * 33]); o.y = pk2(s[2 * 33], s[3 * 33]); o.z = pk2(s[4 * 33], s[5 * 33]); o.w = pk2(s[6 * 33], s[7 * 33]);
        *(v4u*)(WT + (size_t)(dst0 + n) * K + k0 + 8 * c) = o; }
    LDS_WAIT(); asm volatile("" ::: "memory");
}

struct TrItem { const float* W; int ldw, src0, K, k0; bf16* WT; int dst0; const float* gain; };
__device__ __forceinline__ void tr_load(const TrItem& t, float (&w)[32], int lane) {
#pragma unroll
    for (int i = 0; i < 32; ++i) { const int kk = 2 * i + (lane >> 5); w[i] = t.W[(size_t)(t.k0 + kk) * t.ldw + t.src0 + (lane & 31)]; }
}
__device__ __forceinline__ void tr_store(const TrItem& t, const float (&w)[32], LAS float* scr, int lane) {
#pragma unroll
    for (int i = 0; i < 32; ++i) { const int kk = 2 * i + (lane >> 5); scr[kk * 33 + (lane & 31)] = t.gain ? w[i] * t.gain[t.k0 + kk] : w[i]; }
    LDS_WAIT(); asm volatile("" ::: "memory");
    const int c = lane & 7;
#pragma unroll
    for (int j = 0; j < 4; ++j) { const int n = (lane >> 3) + 8 * j; const LAS float* s = scr + (8 * c) * 33 + n;
        v4u o; o.x = pk2(s[0 * 33], s[1 * 33]); o.y = pk2(s[2 * 33], s[3 * 33]); o.z = pk2(s[4 * 33], s[5 * 33]); o.w = pk2(s[6 * 33], s[7 * 33]);
        *(v4u*)(t.WT + (size_t)(t.dst0 + n) * t.K + t.k0 + 8 * c) = o; }
    LDS_WAIT(); asm volatile("" ::: "memory");
}

__device__ __forceinline__ void norm_rows2(const float* x0, const float* x1, const float* nw, const float* sc0, const float* sh0, const float* sc1, const float* sh1, bf16* o0, bf16* o1, int lane) {
    const f32x4* xr0 = (const f32x4*)x0 + lane; const f32x4* xr1 = (const f32x4*)x1 + lane;
    f32x4 v0[4], v1[4]; float s0 = 0.f, s1 = 0.f;
#pragma unroll
    for (int j = 0; j < 4; ++j) { v0[j] = xr0[64 * j]; v1[j] = xr1[64 * j]; }
#pragma unroll
    for (int j = 0; j < 4; ++j) { s0 += (v0[j].x * v0[j].x + v0[j].y * v0[j].y) + (v0[j].z * v0[j].z + v0[j].w * v0[j].w); s1 += (v1[j].x * v1[j].x + v1[j].y * v1[j].y) + (v1[j].z * v1[j].z + v1[j].w * v1[j].w); }
#pragma unroll
    for (int o = 1; o < 64; o <<= 1) { s0 += __shfl_xor(s0, o); s1 += __shfl_xor(s1, o); }
    const float r0 = 1.0f / sqrtf(s0 * (1.0f / 1024.0f) + 1e-6f), r1 = 1.0f / sqrtf(s1 * (1.0f / 1024.0f) + 1e-6f);
    unsigned long long* p0 = (unsigned long long*)o0 + lane; unsigned long long* p1 = (unsigned long long*)o1 + lane;
#pragma unroll
    for (int j = 0; j < 4; ++j) {
        const f32x4 w = ((const f32x4*)nw)[lane + 64 * j];
        const f32x4 a0 = ((const f32x4*)sc0)[lane + 64 * j], b0 = ((const f32x4*)sh0)[lane + 64 * j], a1 = ((const f32x4*)sc1)[lane + 64 * j], b1 = ((const f32x4*)sh1)[lane + 64 * j];
        const f32x4 y0 = v0[j] * r0 * w * (a0 + 1.0f) + b0, y1 = v1[j] * r1 * w * (a1 + 1.0f) + b1;
        p0[64 * j] = (unsigned long long)pk2(y0.x, y0.y) | ((unsigned long long)pk2(y0.z, y0.w) << 32);
        p1[64 * j] = (unsigned long long)pk2(y1.x, y1.y) | ((unsigned long long)pk2(y1.z, y1.w) << 32);
    }
}

constexpr int KVP = 144, KT_BYTES = 2 * 64 * KVP, BUF_BYTES = 2 * KT_BYTES;
constexpr int ATT_SC = 2 * BUF_BYTES, ATT_XS = ATT_SC + 8 * 64 * 4, OSP = 68;
__device__ __forceinline__ int crow(int r, int hi) { return (r & 3) + 8 * (r >> 2) + 4 * hi; }
__device__ __forceinline__ unsigned cvtpk(float lo, float hi) { return pg8::cvt_pk_bf16(lo, hi); }

#define ATT_THR 6.0f
__device__ __forceinline__ float max3f(float a, float b, float c) { float r; asm("v_max3_f32 %0, %1, %2, %3" : "=v"(r) : "v"(a), "v"(b), "v"(c)); return r; }
__device__ __forceinline__ float rowmax32(const f32x16& a, const f32x16& b) {
    float t[16];
#pragma unroll
    for (int r = 0; r < 16; ++r) t[r] = fmaxf(a[r], b[r]);
    float m0 = max3f(t[0], t[1], t[2]), m1 = max3f(t[3], t[4], t[5]);
    m0 = max3f(m0, t[6], t[7]); m1 = max3f(m1, t[8], t[9]); m0 = max3f(m0, t[10], t[11]); m1 = max3f(m1, t[12], t[13]); m0 = max3f(m0, t[14], t[15]);
    return fmaxf(m0, m1);
}
constexpr int ATT_SLOT = 16384, ATT_KR = 0, ATT_VR = 3 * ATT_SLOT, ATT_SC2 = 6 * ATT_SLOT, ATT_XS2 = ATT_SC2 + 8 * 64 * 4;
__device__ __forceinline__ void attn_unit(LAS unsigned char* lds, const bf16* Pq, int m0, const bf16* Kb, const bf16* Vb, int T, bf16* mrg) {
    const int tid = threadIdx.x, lane = tid & 63, r32 = lane & 31, hi = lane >> 5, wid = __builtin_amdgcn_readfirstlane(tid >> 6), kvh = wid >> 2;
    bf16x8 qr[4];
    { const bf16* qp = Pq + (size_t)(m0 + r32) * IN_DIM + wid * 64 + hi * 8;
#pragma unroll
      for (int d0 = 0; d0 < 4; ++d0) qr[d0] = *(const bf16x8*)(qp + d0 * 16); }
    const bf16* ksrc[2]; const bf16* vsrc[2];
#pragma unroll
    for (int i = 0; i < 2; ++i) { const int j = wid + 8 * i, kh = j >> 3, row = 8 * (j & 7) + (lane >> 3), c = (lane & 7) ^ ((row >> 1) & 7);
        ksrc[i] = Kb + ((size_t)(kh * T + row)) * 64 + c * 8; vsrc[i] = Vb + ((size_t)(kh * 64 + row)) * T + c * 8; }
    const int NT = T >> 6;
#define DMA_K(tk, sk) do { _Pragma("unroll") for (int i = 0; i < 2; ++i) \
        __builtin_amdgcn_global_load_lds((const unsigned*)(ksrc[i] + (size_t)(tk) * 64 * 64), (LAS unsigned*)(lds + ATT_KR + (sk) * ATT_SLOT + (wid + 8 * i) * 1024), 16, 0, 0); } while (0)
#define DMA_V(tv, sv) do { _Pragma("unroll") for (int i = 0; i < 2; ++i) \
        __builtin_amdgcn_global_load_lds((const unsigned*)(vsrc[i] + (tv) * 64), (LAS unsigned*)(lds + ATT_VR + (sv) * ATT_SLOT + (wid + 8 * i) * 1024), 16, 0, 0); } while (0)
#define DMA_KV(tk, sk, tv, sv) do { DMA_K(tk, sk); DMA_V(tv, sv); } while (0)
    DMA_KV(0, 0, 0, 0); DMA_K(1, 1); DMA_KV(2, 2, 1, 1);
    const int pr = (r32 & ~12) | ((r32 & 4) << 1) | ((r32 & 8) >> 1);
    int koffs[4], voffs[4];
#pragma unroll
    for (int d0 = 0; d0 < 4; ++d0) { koffs[d0] = kvh * 8192 + pr * 128 + (((2 * d0 + hi) ^ ((pr >> 1) & 7)) << 4); voffs[d0] = kvh * 8192 + r32 * 128 + (((2 * d0 + hi) ^ ((r32 >> 1) & 7)) << 4); }
    LAS float* sc = (LAS float*)(lds + ATT_SC2) + wid * 64;
    const unsigned ldsb = (unsigned)(uintptr_t)lds;
#define DSR(dst, addr, off) asm volatile("ds_read_b128 %0, %1 offset:%2" : "=v"(dst) : "v"(addr), "i"(off) : "memory")
    asm volatile("s_waitcnt vmcnt(4)" ::: "memory"); __builtin_amdgcn_s_barrier(); asm volatile("" ::: "memory");
    f32x16 o0 = {}, o1 = {}, o2 = {};
    const bf16x8 ones = {16256, 16256, 16256, 16256, 16256, 16256, 16256, 16256};
    f32x16 c0 = {}, c1 = {}, n0, n1;
#pragma unroll
    for (int d0 = 0; d0 < 4; ++d0) {
        const bf16x8 k0 = *(const LAS bf16x8*)(lds + ATT_KR + koffs[d0]), k1 = *(const LAS bf16x8*)(lds + ATT_KR + koffs[d0] + 32 * 128);
        c0 = __builtin_amdgcn_mfma_f32_32x32x16_bf16(k0, qr[d0], c0, 0, 0, 0);
        c1 = __builtin_amdgcn_mfma_f32_32x32x16_bf16(k1, qr[d0], c1, 0, 0, 0);
    }
    asm volatile("s_waitcnt lgkmcnt(0)" ::: "memory"); __builtin_amdgcn_s_barrier(); asm volatile("" ::: "memory");
    float mrun = rowmax32(c0, c1), rmc = 0.f; mrun = fmaxf(mrun, __shfl_xor(mrun, 32));
#pragma unroll
    for (int r = 0; r < 16; ++r) { c0[r] -= mrun; c1[r] -= mrun; }
    int sk1 = 1, sv0 = 0;
#define ATT_ITER(t, MORE, C0, C1, N0, N1) do { \
        const bool dk_ = (t) + 3 < NT, dv_ = (t) + 2 < NT;       \
        { const int skn_ = sk1 == 0 ? 2 : sk1 - 1, svn_ = sv0 == 0 ? 2 : sv0 - 1; if (dk_) DMA_K((t) + 3, skn_); if (dv_) DMA_V((t) + 2, svn_); } \
        if (__any(rmc > ATT_THR)) { \
            const float rmf_ = fmaxf(rmc, __shfl_xor(rmc, 32)); const float dl = fmaxf(rmf_, 0.f), alpha = __builtin_amdgcn_exp2f(-dl); mrun += dl; \
            _Pragma("unroll") for (int r = 0; r < 16; ++r) { C0[r] -= dl; C1[r] -= dl; } \
            if (hi == 0) sc[r32] = alpha; \
            _Pragma("unroll") for (int g = 0; g < 4; ++g) { const f32x4 a4 = *(const LAS f32x4*)(sc + 8 * g + 4 * hi); \
                _Pragma("unroll") for (int i = 0; i < 4; ++i) { o0[4 * g + i] *= a4[i]; o1[4 * g + i] *= a4[i]; o2[4 * g + i] *= a4[i]; } } \
        } \
        bf16x8 kf_[8], vf_[8]; \
        { const unsigned kb_ = ldsb + ATT_KR + sk1 * ATT_SLOT, vb_ = ldsb + ATT_VR + sv0 * ATT_SLOT; \
          if (MORE) { _Pragma("unroll") for (int d0 = 0; d0 < 4; ++d0) { DSR(kf_[2 * d0], kb_ + koffs[d0], 0); DSR(kf_[2 * d0 + 1], kb_ + koffs[d0], 4096); } } \
          _Pragma("unroll") for (int s4 = 0; s4 < 2; ++s4) { DSR(vf_[2 * s4], vb_ + voffs[s4], 0); DSR(vf_[2 * s4 + 1], vb_ + voffs[s4], 4096); } \
          asm volatile("s_waitcnt lgkmcnt(4)" ::: "memory"); __builtin_amdgcn_sched_barrier(0);        \
          _Pragma("unroll") for (int s4 = 2; s4 < 4; ++s4) { DSR(vf_[2 * s4], vb_ + voffs[s4], 0); DSR(vf_[2 * s4 + 1], vb_ + voffs[s4], 4096); } } \
        if (MORE) { f32x16 negm; _Pragma("unroll") for (int r = 0; r < 16; ++r) negm[r] = -mrun; \
              _Pragma("unroll") for (int d0 = 0; d0 < 4; ++d0) { \
              N0 = __builtin_amdgcn_mfma_f32_32x32x16_bf16(kf_[2 * d0], qr[d0], d0 == 0 ? negm : N0, 0, 0, 0); \
              N1 = __builtin_amdgcn_mfma_f32_32x32x16_bf16(kf_[2 * d0 + 1], qr[d0], d0 == 0 ? negm : N1, 0, 0, 0); } } \
        _Pragma("unroll") for (int r = 0; r < 16; ++r) { C0[r] = __builtin_amdgcn_exp2f(C0[r]); C1[r] = __builtin_amdgcn_exp2f(C1[r]); } \
        v4u pw[4]; \
        _Pragma("unroll") for (int s2 = 0; s2 < 2; ++s2) { \
            pw[s2]     = (v4u){cvtpk(C0[8 * s2], C0[8 * s2 + 1]), cvtpk(C0[8 * s2 + 2], C0[8 * s2 + 3]), cvtpk(C0[8 * s2 + 4], C0[8 * s2 + 5]), cvtpk(C0[8 * s2 + 6], C0[8 * s2 + 7])}; \
            pw[2 + s2] = (v4u){cvtpk(C1[8 * s2], C1[8 * s2 + 1]), cvtpk(C1[8 * s2 + 2], C1[8 * s2 + 3]), cvtpk(C1[8 * s2 + 4], C1[8 * s2 + 5]), cvtpk(C1[8 * s2 + 6], C1[8 * s2 + 7])}; } \
        asm volatile("s_waitcnt lgkmcnt(0)" ::: "memory"); __builtin_amdgcn_sched_barrier(0); \
        _Pragma("unroll") for (int s4 = 0; s4 < 4; ++s4) { \
            o0 = __builtin_amdgcn_mfma_f32_32x32x16_bf16(__builtin_bit_cast(bf16x8, pw[s4]), vf_[2 * s4], o0, 0, 0, 0); \
            o1 = __builtin_amdgcn_mfma_f32_32x32x16_bf16(__builtin_bit_cast(bf16x8, pw[s4]), vf_[2 * s4 + 1], o1, 0, 0, 0); \
            o2 = __builtin_amdgcn_mfma_f32_32x32x16_bf16(__builtin_bit_cast(bf16x8, pw[s4]), ones, o2, 0, 0, 0); } \
        rmc = MORE ? rowmax32(N0, N1) : 0.f; \
        sk1 = sk1 == 2 ? 0 : sk1 + 1; sv0 = sv0 == 2 ? 0 : sv0 + 1; \
        if (dk_) asm volatile("s_waitcnt vmcnt(4)" ::: "memory"); else if (dv_) asm volatile("s_waitcnt vmcnt(2)" ::: "memory"); else asm volatile("s_waitcnt vmcnt(0)" ::: "memory");     \
        asm volatile("s_waitcnt lgkmcnt(0)" ::: "memory"); __builtin_amdgcn_s_barrier(); asm volatile("" ::: "memory"); \
    } while (0)
    int t = 0;
    for (; t < NT - 2; t += 2) {
        ATT_ITER(t, true, c0, c1, n0, n1);
        ATT_ITER(t + 1, true, n0, n1, c0, c1);
    }
    ATT_ITER(t, true, c0, c1, n0, n1);
    ATT_ITER(t + 1, false, n0, n1, c0, c1);
#undef ATT_ITER
#undef DMA_KV
#undef DMA_K
#undef DMA_V
#undef DSR
    asm volatile("s_waitcnt vmcnt(0)" ::: "memory"); __builtin_amdgcn_s_barrier(); asm volatile("" ::: "memory");
    LAS float* st = (LAS float*)lds + wid * (32 * OSP);
#pragma unroll
    for (int r = 0; r < 16; ++r) { const float rl = 1.0f / o2[r]; st[crow(r, hi) * OSP + r32] = o0[r] * rl; st[crow(r, hi) * OSP + 32 + r32] = o1[r] * rl; }
    const int q = lane >> 1, hf = lane & 1;
    f32x4 ov[8]; float ss = 0.f;
#pragma unroll
    for (int i = 0; i < 8; ++i) { ov[i] = *(const LAS f32x4*)(st + q * OSP + 32 * hf + 4 * i); ss += (ov[i].x * ov[i].x + ov[i].y * ov[i].y) + (ov[i].z * ov[i].z + ov[i].w * ov[i].w); }
    ss += __shfl_xor(ss, 1);
    LAS float* xs = (LAS float*)(lds + ATT_XS2);
    if (hf == 0) xs[wid * 32 + q] = ss;
    __syncthreads();
    float tot = 0.f;
#pragma unroll
    for (int w = 0; w < 8; ++w) tot += xs[w * 32 + q];
    const float rinv = 1.0f / sqrtf(tot * (1.0f / 512.0f) + 1e-6f);
    bf16* op = mrg + (size_t)(m0 + q) * D + wid * 64 + 32 * hf;
#pragma unroll
    for (int i = 0; i < 4; ++i) { const f32x4 a = ov[2 * i] * rinv, b = ov[2 * i + 1] * rinv; v4u w; w.x = pk2(a.x, a.y); w.y = pk2(a.z, a.w); w.z = pk2(b.x, b.y); w.w = pk2(b.z, b.w); *(v4u*)(op + 8 * i) = w; }
    __syncthreads();
}

__device__ __forceinline__ void unpack8(const v4u v, float (&f)[8]) {
#pragma unroll
    for (int i = 0; i < 4; ++i) { f[2 * i] = __builtin_bit_cast(float, v[i] << 16); f[2 * i + 1] = __builtin_bit_cast(float, v[i] & 0xffff0000u); }
}
__device__ __forceinline__ void conv_run6(const bf16* P, const float* cw, int m0, bf16* mrg, int lane) {
    v4u gcr[8], ur[8], gbr[6];
#pragma unroll
    for (int i = 0; i < 8; ++i) { int m = m0 - 1 + i; m = m < 0 ? 0 : (m > M_ALL - 1 ? M_ALL - 1 : m); const bf16* row = P + (size_t)m * IN_DIM + 8 * lane; gcr[i] = *(const v4u*)(row + 1280); ur[i] = *(const v4u*)(row + 1792); }
#pragma unroll
    for (int i = 0; i < 6; ++i) gbr[i] = *(const v4u*)(P + (size_t)(m0 + i) * IN_DIM + 8 * lane + 768);
    float w0[8], w1[8], w2[8];
#pragma unroll
    for (int i = 0; i < 8; ++i) { w0[i] = cw[8 * lane + i]; w1[i] = cw[512 + 8 * lane + i]; w2[i] = cw[1024 + 8 * lane + i]; }
    float z[8][8];
#pragma unroll
    for (int i = 0; i < 8; ++i) { float a[8], b[8]; unpack8(gcr[i], a); unpack8(ur[i], b);
#pragma unroll
        for (int c = 0; c < 8; ++c) z[i][c] = a[c] * b[c]; }
#pragma unroll
    for (int t = 0; t < 6; ++t) {
        const int m = m0 + t; const int s = m < M_CTX ? (m & 255) : ((m - M_CTX) & 1023), L = m < M_CTX ? 256 : 1024;
        const float fp = s > 0 ? 1.0f : 0.0f, fn = s < L - 1 ? 1.0f : 0.0f;
        float g[8], y[8]; unpack8(gbr[t], g); float ss = 0.f;
#pragma unroll
        for (int c = 0; c < 8; ++c) { y[c] = g[c] * (w0[c] * fp * z[t][c] + w1[c] * z[t + 1][c] + w2[c] * fn * z[t + 2][c]); ss += y[c] * y[c]; }
        const float rinv = 1.0f / sqrtf(wave_sum(ss) * (1.0f / 512.0f) + 1e-6f);
        v4u o; o.x = pk2(y[0] * rinv, y[1] * rinv); o.y = pk2(y[2] * rinv, y[3] * rinv); o.z = pk2(y[4] * rinv, y[5] * rinv); o.w = pk2(y[6] * rinv, y[7] * rinv);
        *(v4u*)(mrg + (size_t)m * D + 512 + 8 * lane) = o;
    }
}

#define XB_TMO      128
#define XB_XCNT(j)  (256  + 64 * (j))
#define XB_XSUB(j)  (1280 + 64 * (j))
#define XB_XGEN(j)  (2304 + 64 * (j))
#define XB_TOP      3328
#define XB_TOPGEN   3392
#define XCD_BAR_WORDS 3456
#define XB_SPIN_CAP (1u << 18)

__device__ __forceinline__ unsigned xb_ld(unsigned* p)              { return __hip_atomic_load(p, __ATOMIC_RELAXED, __HIP_MEMORY_SCOPE_AGENT); }
__device__ __forceinline__ unsigned xb_add(unsigned* p, unsigned v) { return __hip_atomic_fetch_add(p, v, __ATOMIC_RELAXED, __HIP_MEMORY_SCOPE_AGENT); }
__device__ __forceinline__ unsigned xb_xcc_id() { return (unsigned)__builtin_amdgcn_s_getreg((3 << 11) | 20) & 0xFu; }
#define XB_SPIN(cond, bar) do { unsigned _sp = 0; while (cond) { __builtin_amdgcn_s_sleep(1); \
    if ((++_sp & 255u) == 0u) { if (xb_ld(&(bar)[XB_TMO])) break; if (_sp > XB_SPIN_CAP) { atomicAdd(&(bar)[XB_TMO], 1u); break; } } } } while (0)

struct XcdBarrier {
    unsigned* bar; unsigned x;
    volatile LAS unsigned* st;
};

__device__ __forceinline__ XcdBarrier xcd_barrier_post(unsigned* bar, volatile LAS unsigned* st) {
    XcdBarrier b; b.bar = bar; b.x = xb_xcc_id(); b.st = st;
    if (threadIdx.x == 0) (void)xb_add(&bar[XB_XCNT(b.x)], 1u);
    return b;
}
__device__ __forceinline__ void xcd_barrier_complete(unsigned* bar, unsigned x, unsigned& nloc, unsigned& nx) {
    const unsigned G = gridDim.x * gridDim.y * gridDim.z;
    unsigned sum, cnt, mine, sp = 0u;
    for (;;) {
        sum = 0u; cnt = 0u; mine = 0u;
#pragma unroll
        for (unsigned j = 0; j < 16; ++j) { const unsigned c = xb_ld(&bar[XB_XCNT(j)]); sum += c; cnt += (c > 0u) ? 1u : 0u; mine = (j == x) ? c : mine; }
        if (sum == G) break;
        __builtin_amdgcn_s_sleep(1);
        if ((++sp & 255u) == 0u) { if (xb_ld(&bar[XB_TMO])) break; if (sp > XB_SPIN_CAP) { atomicAdd(&bar[XB_TMO], 1u); break; } }
    }
    nloc = mine > 0u ? mine : 1u; nx = cnt > 0u ? cnt : 1u;
}

__device__ __forceinline__ void xcd_barrier(const XcdBarrier& b) {
    asm volatile("s_waitcnt vmcnt(0)" ::: "memory");
    __syncthreads();
    if (threadIdx.x == 0) {
        unsigned* bar = b.bar;
        __builtin_amdgcn_s_waitcnt(0);
        unsigned nloc = b.st[0], nx = b.st[1];
        if (nloc == 0u) { xcd_barrier_complete(bar, b.x, nloc, nx); b.st[0] = nloc; b.st[1] = nx; }
        const unsigned old = xb_add(&bar[XB_XSUB(b.x)], 1u);
        const unsigned gen = old / nloc;
        if (old + 1u == (gen + 1u) * nloc) {
            __builtin_amdgcn_fence(__ATOMIC_RELEASE, "agent");
            asm volatile("s_waitcnt vmcnt(0)" ::: "memory");
            const unsigned og = xb_add(&bar[XB_TOP], 1u);
            const unsigned tg = og / nx;
            if (og + 1u == (tg + 1u) * nx) xb_add(&bar[XB_TOPGEN], 1u);
            else XB_SPIN(xb_ld(&bar[XB_TOPGEN]) == tg, bar);
            __builtin_amdgcn_fence(__ATOMIC_ACQUIRE, "agent");
            xb_add(&bar[XB_XGEN(b.x)], 1u);
            asm volatile("s_waitcnt vmcnt(0)" ::: "memory");
        } else {
            XB_SPIN(xb_ld(&bar[XB_XGEN(b.x)]) == gen, bar);
            __builtin_amdgcn_fence(__ATOMIC_ACQUIRE, "agent");
            asm volatile("s_waitcnt vmcnt(0)" ::: "memory");
        }
    }
    __syncthreads();
}

__global__ void __launch_bounds__(NTHREADS, 2) fwd_kernel(Args a) {
    extern __shared__ __attribute__((aligned(16))) unsigned char lds_raw[];
    LAS unsigned char* lds = (LAS unsigned char*)lds_raw;
    cg::grid_group grid = cg::this_grid();
    const int tid = threadIdx.x, lane = tid & 63, wave = __builtin_amdgcn_readfirstlane(tid >> 6);
    const int G = gridDim.x, bx = blockIdx.x;
    const int vcu = (G % 8 == 0) ? (bx % 8) * (G / 8) + bx / 8 : bx;
    unsigned char* ws = a.ws;
    float* mod = (float*)(ws + WS_MOD); float* rope = (float*)(ws + WS_ROPE);
    bf16* Win = (bf16*)(ws + WS_WIN); bf16* Wout = (bf16*)(ws + WS_WOUT); bf16* Wgu = (bf16*)(ws + WS_WGU); bf16* Wdn = (bf16*)(ws + WS_WDN);
    bf16* Kl = (bf16*)(ws + WS_KL); bf16* Vl = (bf16*)(ws + WS_VL); bf16* Kc = (bf16*)(ws + WS_KC); bf16* Vc = (bf16*)(ws + WS_VC);
    bf16* H = (bf16*)(ws + WS_H); bf16* P = (bf16*)(ws + WS_P); bf16* MRG = (bf16*)(ws + WS_MRG); bf16* ACT = (bf16*)(ws + WS_ACT); float* X1 = a.out;
    float* newk = a.out + (size_t)M_ALL * D; float* newv = newk + 16 * 256 * 128;
    const int lo = a.ph_lo, hi = a.ph_hi;
#define IN(k) (lo <= (k) && (k) < hi)
#define SEAM(k) do { if (IN(k) && IN((k) + 1)) xcd_barrier(bar); } while (0)
    volatile LAS unsigned* misc = (volatile LAS unsigned*)(lds + LDS_BYTES - 256);
    if (tid < 64) misc[tid] = 0u;
    __syncthreads();
    XcdBarrier bar = xcd_barrier_post((unsigned*)ws + a.li * XCD_BAR_WORDS, misc);
    if (a.ph_lo < 0) grid.sync();

    if (IN(0)) {
        if (bx < 96) {
            LAS float* sl = (LAS float*)lds;
            for (int i = tid; i < 9 * 1024; i += NTHREADS) { const float v = i < 8192 ? a.c[i] : a.c_ctx[i - 8192]; sl[i] = v / (1.0f + __expf(-v)); }
            __syncthreads();
            const int cgp = lane & 15, ks = lane >> 4;
            f32x4 acc[9];
#pragma unroll
            for (int r = 0; r < 9; ++r) acc[r] = (f32x4){0.f, 0.f, 0.f, 0.f};
            const float* wp = a.w_ada + (size_t)(128 * wave + ks) * MODW + 64 * bx + 4 * cgp;
#pragma unroll 1
            for (int i0 = 0; i0 < 32; i0 += 16) {
                f32x4 w[16];
#pragma unroll
                for (int j = 0; j < 16; ++j) w[j] = *(const f32x4*)(wp + (size_t)(4 * (i0 + j)) * MODW);
#pragma unroll
                for (int j = 0; j < 16; ++j) { const int k = 128 * wave + 4 * (i0 + j) + ks;
#pragma unroll
                    for (int r = 0; r < 9; ++r) acc[r] += w[j] * sl[r * 1024 + k]; }
            }
            LAS float* red = (LAS float*)(lds + 40960);
#pragma unroll
            for (int r = 0; r < 9; ++r) {
#pragma unroll
                for (int j = 0; j < 4; ++j) { float v = acc[r][j]; v += __shfl_xor(v, 16); v += __shfl_xor(v, 32); acc[r][j] = v; }
                if (ks == 0) *(LAS f32x4*)(red + (wave * 9 + r) * 64 + 4 * cgp) = acc[r];
            }
            __syncthreads();
            for (int i = tid; i < 9 * 64; i += NTHREADS) { const int r = i >> 6, l = i & 63; float s = a.b_ada[64 * bx + l];
#pragma unroll
                for (int w = 0; w < 8; ++w) s += red[(w * 9 + r) * 64 + l];
                mod[r * MODW + 64 * bx + l] = s; }
            __syncthreads();
        }
        {
            LAS float* scr = (LAS float*)(lds + wave * 17408);
            const int gw = bx * NWAVES + wave, NGW = G * NWAVES;
            constexpr int I_IN = 16 * 72, I_OUT = 16 * 32, I_GU = 16 * 176, I_DN = 44 * 32;
            const bool bal = (G == 256);
            const int nhere = bal ? I_IN + I_OUT + I_DN : I_IN + I_OUT + I_DN + I_GU;
            const int nit = bal ? (bx < 96 ? 0 : ((bx - 96) * NWAVES + wave < 512 ? 3 : 2)) : (nhere - gw + NGW - 1) / NGW;
            auto decode = [&](int ii) -> TrItem {
                const int it = bal ? (bx - 96) * NWAVES + wave + 1280 * ii : gw + ii * NGW;
                int r = it; TrItem t;
                if (r < I_IN) { const int kb = r / 72, db = r % 72, pn = db >> 3, bj = (db >> 2) & 1, wc = db & 3; const int src = pn < 3 ? 64 * (4 * pn + wc) + 32 * bj : 32 * db;
                    t = TrItem{a.w_in, IN_DIM, src, D, 64 * kb, Win, 32 * db, nullptr}; return t; } r -= I_IN;
                if (r < I_OUT) { const int kb = r / 32, db = r % 32; t = TrItem{a.w_out, D, 32 * db, D, 64 * kb, Wout, 32 * db, kb < 8 ? a.aon : a.con - 512}; return t; } r -= I_OUT;
                if (r < I_DN) { const int kb = r / 32, db = r % 32; t = TrItem{a.w_dn, D, 32 * db, D_FF, 64 * kb, Wdn, 32 * db, nullptr}; return t; } r -= I_DN;
                { const int kb = r / 176, db = r % 176, pn = db >> 3, bj = (db >> 2) & 1, qq = db & 3; const int src = (bj ? D_FF : 0) + 128 * pn + 32 * qq;
                    t = TrItem{a.w_gu, NGU, src, D, 64 * kb, Wgu, 32 * db, nullptr}; return t; }
            };
            int ii = 0;
            if (nit == 3) {
                const TrItem t0 = decode(0), t1 = decode(1), t2 = decode(2);
                float w0[32], w1[32], w2[32];
                tr_load(t0, w0, lane); tr_load(t1, w1, lane); tr_load(t2, w2, lane);
                tr_store(t0, w0, scr, lane); tr_store(t1, w1, scr + 2176, lane); tr_store(t2, w2, scr, lane);
                ii = 3;
            }
            for (; ii + 1 < nit; ii += 2) {
                const TrItem t0 = decode(ii), t1 = decode(ii + 1);
                float w0[32], w1[32];
                tr_load(t0, w0, lane); tr_load(t1, w1, lane);
                tr_store(t0, w0, scr, lane); tr_store(t1, w1, scr + 2176, lane);
            }
            if (ii < nit) { const TrItem t0 = decode(ii); float w0[32]; tr_load(t0, w0, lane); tr_store(t0, w0, scr, lane); }
        }
        {
            const int gt = bx * NTHREADS + tid, NGT = G * NTHREADS;
            for (int i = gt; i < 8 * 256 * 128; i += NGT) { const int d = i & 63, kh = (i >> 6) & 1, key = (i >> 7) & 255, b = i >> 15;
                Kl[((size_t)(b * 2 + kh) * 1280 + key) * 64 + d] = (bf16)f2bf(a.cache_k[i]);
                Vl[((size_t)(b * 2 + kh) * 64 + d) * 1280 + key] = (bf16)f2bf(a.cache_v[i]); }
            if (gt < 1024) { const int pos = gt >> 4, p = gt & 15; const float inv = 1.0f / powf(10000.0f, (float)p / 16.0f); const float ang = (float)pos * inv; rope[gt] = cosf(ang); rope[1024 + gt] = sinf(ang); }
        }
    }
    SEAM(0);
    if (IN(1)) {
        const int gw = vcu * NWAVES + wave, NGW = G * NWAVES;
        for (int m = gw; m < M_ALL; m += 2 * NGW) {
            const int m2 = m + NGW < M_ALL ? m + NGW : m;
            const float* xa = m < M_CTX ? a.xp + (size_t)m * D : a.xs + (size_t)(m - M_CTX) * D;
            const float* xb = m2 < M_CTX ? a.xp + (size_t)m2 * D : a.xs + (size_t)(m2 - M_CTX) * D;
            const float* ma = mod + (size_t)(m < M_CTX ? 8 : (m - M_CTX) >> 10) * MODW;
            const float* mb = mod + (size_t)(m2 < M_CTX ? 8 : (m2 - M_CTX) >> 10) * MODW;
            norm_rows2(xa, xb, a.norm_mix, ma + 1024, ma, mb + 1024, mb, H + (size_t)m * D, H + (size_t)m2 * D, lane);
        }
    }
    SEAM(1);
    if (IN(2)) {
        pg8::Gemm g{H, Win, M_ALL, IN_DIM, D}; pg8::StaticOrder S; S.init(M_ALL, IN_DIM, G, bx);
        pg8::EpiIn E{P, Kl, Vl, Kc, Vc, newk, newv, a.q_norm, a.k_norm, rope};
        pg8::gemm_phase<pg8::EpiIn, pg8::StaticOrder, true, true>(lds, g, S, E);
        if (G == 256 && bx >= 176) {
            LAS float* scr = (LAS float*)(lds + wave * 17408);
            constexpr int I_GU = 16 * 176;
            for (int it = (bx - 176) * NWAVES + wave; it < I_GU; it += 2 * 80 * NWAVES) {
                const int it2 = it + 80 * NWAVES;
                auto dec = [&](int r) -> TrItem { const int kb = r / 176, db = r % 176, pn = db >> 3, bj = (db >> 2) & 1, qq = db & 3; const int src = (bj ? D_FF : 0) + 128 * pn + 32 * qq; return TrItem{a.w_gu, NGU, src, D, 64 * kb, Wgu, 32 * db, nullptr}; };
                const TrItem t0 = dec(it); float w0[32]; tr_load(t0, w0, lane);
                if (it2 < I_GU) { const TrItem t1 = dec(it2); float w1[32]; tr_load(t1, w1, lane); tr_store(t0, w0, scr, lane); tr_store(t1, w1, scr + 2176, lane); }
                else tr_store(t0, w0, scr, lane);
            }
        }
    }
    SEAM(2);
    if (IN(3)) {
        for (int u = vcu; u < 384; u += G) {
            if (u < 256) { const int b = u >> 5, qb = u & 31; attn_unit(lds, P, M_CTX + b * 1024 + qb * 32, Kl + (size_t)b * 2 * 1280 * 64, Vl + (size_t)b * 2 * 64 * 1280, 1280, MRG); }
            else { const int b = (u - 256) >> 3, qb = (u - 256) & 7; attn_unit(lds, P, b * 256 + qb * 32, Kc + (size_t)b * 2 * 256 * 64, Vc + (size_t)b * 2 * 64 * 256, 256, MRG); }
        }
        const int gw = vcu * NWAVES + wave, NGW = G * NWAVES;
        if (G == 256) { if (vcu >= 128) { const int w2 = (vcu - 128) * NWAVES + wave; conv_run6(P, a.conv_w, 6 * w2, MRG, lane); conv_run6(P, a.conv_w, 6 * (w2 + 1024), MRG, lane); } }
        else for (int r = gw; r < M_ALL / 6; r += NGW) conv_run6(P, a.conv_w, 6 * r, MRG, lane);
    }
    SEAM(3);
    if (IN(4)) {
        pg8::Gemm g{MRG, Wout, M_ALL, D, D}; pg8::StaticOrder S; S.init(M_ALL, D, G, bx, 192);
        pg8::EpiRes3 E{a.xp, a.xs, X1, mod + 2048};
        pg8::gemm_phase<pg8::EpiRes3, pg8::StaticOrder, true, true>(lds, g, S, E);
    }
    SEAM(4);
    if (IN(5)) {
        const int gw = vcu * NWAVES + wave, NGW = G * NWAVES;
        for (int m = gw; m < M_ALL; m += 2 * NGW) {
            const int m2 = m + NGW < M_ALL ? m + NGW : m;
            const float* ma = mod + (size_t)(m < M_CTX ? 8 : (m - M_CTX) >> 10) * MODW;
            const float* mb = mod + (size_t)(m2 < M_CTX ? 8 : (m2 - M_CTX) >> 10) * MODW;
            norm_rows2(X1 + (size_t)m * D, X1 + (size_t)m2 * D, a.norm_ffn, ma + 4096, ma + 3072, mb + 4096, mb + 3072, H + (size_t)m * D, H + (size_t)m2 * D, lane);
        }
    }
    SEAM(5);
    if (IN(6)) {
        pg8::Gemm g{H, Wgu, M_ALL, NGU, D}; pg8::StaticOrder S; S.init(M_ALL, NGU, G, bx, 192);
        pg8::EpiSwiGLU3 E{ACT, D_FF};
        pg8::gemm_phase<pg8::EpiSwiGLU3, pg8::StaticOrder, true, true>(lds, g, S, E);
    }
    SEAM(6);
    if (IN(7)) {
        pg8::Gemm g{ACT, Wdn, M_ALL, D, D_FF}; pg8::StaticOrder S; S.init(M_ALL, D, G, bx, 192);
        pg8::EpiRes3 E{X1, X1 + (size_t)M_CTX * D, a.out, mod + 5120};
        pg8::gemm_phase<pg8::EpiRes3, pg8::StaticOrder, true, true>(lds, g, S, E);
    }
#undef IN
#undef SEAM
}

#ifndef MK_N_LAUNCHES
#define MK_N_LAUNCHES 1
#endif
extern "C" void kernel_launch(void* const* d_in, const int* in_sizes, int n_in, void* d_out, int out_size, void* d_ws, size_t ws_size, hipStream_t stream) {
    static int grid = 0;
    if (grid == 0) {
        int dev = 0, cus = 0, per_cu = 0;
        hipGetDevice(&dev); hipDeviceGetAttribute(&cus, hipDeviceAttributeMultiprocessorCount, dev);
        if (hipFuncSetAttribute((const void*)fwd_kernel, hipFuncAttributeMaxDynamicSharedMemorySize, LDS_BYTES) != hipSuccess) { fprintf(stderr, "kernel_launch: hipFuncSetAttribute failed\n"); grid = -1; return; }
        hipOccupancyMaxActiveBlocksPerMultiprocessor(&per_cu, (const void*)fwd_kernel, NTHREADS, LDS_BYTES);
        (void)hipGetLastError();
        if (per_cu < 1) { fprintf(stderr, "kernel_launch: occupancy query says %d blocks per CU\n", per_cu); per_cu = 1; }
        grid = cus;
        if (n_in != 19 || ws_size < WS_END) { fprintf(stderr, "kernel_launch: unexpected n_in %d / ws %zu\n", n_in, ws_size); grid = -1; return; }
    }
    if (grid < 0) return;
    Args a{};
    a.xp = (const float*)d_in[0]; a.xs = (const float*)d_in[1]; a.c = (const float*)d_in[2]; a.cache_k = (const float*)d_in[3]; a.cache_v = (const float*)d_in[4]; a.c_ctx = (const float*)d_in[5];
    a.norm_mix = (const float*)d_in[6]; a.norm_ffn = (const float*)d_in[7]; a.w_ada = (const float*)d_in[8]; a.b_ada = (const float*)d_in[9]; a.w_in = (const float*)d_in[10];
    a.q_norm = (const float*)d_in[11]; a.k_norm = (const float*)d_in[12]; a.conv_w = (const float*)d_in[13]; a.aon = (const float*)d_in[14]; a.con = (const float*)d_in[15];
    a.w_out = (const float*)d_in[16]; a.w_gu = (const float*)d_in[17]; a.w_dn = (const float*)d_in[18]; a.out = (float*)d_out; a.ws = (unsigned char*)d_ws;
#if MK_N_LAUNCHES == 1
    (void)hipMemsetAsync(d_ws, 0, 65536, stream);
    void* args[] = {&a};
    if (PROBE_DUP >= 0) {
        a.ph_lo = 0; a.ph_hi = PROBE_DUP > 7 ? 0 : PROBE_DUP + 1;
        (void)hipLaunchCooperativeKernel((const void*)fwd_kernel, dim3(grid), dim3(NTHREADS), args, LDS_BYTES, stream);
        a.ph_lo = PROBE_DUP > 7 ? 0 : PROBE_DUP; a.ph_hi = 8; a.li = 1;
    } else { a.ph_lo = 0; a.ph_hi = 8; }
    hipError_t e = hipLaunchCooperativeKernel((const void*)fwd_kernel, dim3(grid), dim3(NTHREADS), args, LDS_BYTES, stream);
    if (e != hipSuccess) fprintf(stderr, "cooperative launch failed: %s (grid %d)\n", hipGetErrorString(e), grid);
#else
    for (int p = 0; p < 8; ++p) { a.ph_lo = p; a.ph_hi = p + 1; hipLaunchKernelGGL(fwd_kernel, dim3(grid), dim3(NTHREADS), LDS_BYTES, stream, a); }
#endif
}
```

```cpp
#include <hip/hip_runtime.h>
#include <hip/hip_cooperative_groups.h>
#include <cstdio>
#include <cstdint>
namespace cg = cooperative_groups;
#ifndef PROBE_DUP
#define PROBE_DUP -1
#endif
namespace pg8 {
#define PG8_LAS __attribute__((address_space(3)))
typedef unsigned short bf16_t;
typedef short bf16x8 __attribute__((ext_vector_type(8)));
typedef float f32x4 __attribute__((ext_vector_type(4)));
typedef unsigned u32x4 __attribute__((ext_vector_type(4)));
constexpr int BM = 256, BK = 64, HALF = 128, HTB = HALF * BK * 2  , STAGE_BYTES = 8 * HTB, NXCD = 8, WGM = 8;

__host__ __device__ __forceinline__ int lds_byte(int r, int c) { const int st = (r >> 4) * 2 + (c >> 5), rr = r & 15, cc = c & 31, ob = rr * 64 + cc * 2; return st * 1024 + (ob ^ (((ob >> 9) & 1) << 5)); }
__host__ __device__ __forceinline__ void stage_rc(int b, int& R, int& C) { const int st = b / 1024, sb = b % 1024, swz = sb ^ (((sb >> 9) & 1) << 5); R = (st >> 1) * 16 + swz / 64; C = (st & 1) * 32 + (swz % 64) / 2; }
__host__ __device__ __forceinline__ int perm32(int rho) { const int n = rho >> 4, i = rho & 15; return 8 * (i >> 2) + 4 * n + (i & 3); }

struct Unit { int pm, pn; };
struct Gemm { const bf16_t* A; const bf16_t* Bt; int M, N, K; };

struct StaticOrder {
    int nM, nN, nwg, G, c;
    __host__ __device__ void init(int M, int N, int G_, int c_, int bm = BM) { nM = M / bm; nN = N / BM; nwg = nM * nN; G = G_; c = c_; }
    __host__ __device__ bool next(int i, Unit& u) const {
        const long L = (long)i * G + c; if (L >= nwg) return false;
        int wgid = (int)L; { const int q = nwg / NXCD, r = nwg % NXCD, xcd = wgid % NXCD, off = wgid / NXCD; wgid = (xcd < r ? xcd * (q + 1) : r * (q + 1) + (xcd - r) * q) + off; }
        const int nig = WGM * nN, gid = wgid / nig, fm = gid * WGM, gsz = (nM - fm) < WGM ? (nM - fm) : WGM;
        u.pm = fm + ((wgid % nig) % gsz); u.pn = (wgid % nig) / gsz; return true;
    }
    __device__ __forceinline__ void a_ready(const Unit&) const {}
    __device__ __forceinline__ void done(const Unit&) const {}
};
typedef float f32x2cv_t __attribute__((ext_vector_type(2))); typedef __bf16 bf16x2cv_t __attribute__((ext_vector_type(2)));
__device__ __forceinline__ unsigned cvt_pk_bf16(float lo, float hi) { f32x2cv_t v = {lo, hi}; bf16x2cv_t b = __builtin_convertvector(v, bf16x2cv_t); return __builtin_bit_cast(unsigned, b); }
typedef float f32x2 __attribute__((ext_vector_type(2)));
template <class Epi, class Sched, bool ALIGN_EPI = false, bool SP2 = false>
__device__ __forceinline__ void gemm_phase(PG8_LAS unsigned char* lds, const Gemm g, const Sched& S, const Epi& E) {
    const int tid = threadIdx.x, wid = __builtin_amdgcn_readfirstlane(tid >> 6), lane = tid & 63, wr = wid >> 2, wc = wid & 3, fr = lane & 15, fq = lane >> 4;
    const int K = g.K, nt = K / BK;
    unsigned voffA[2], voffB[2];
#pragma unroll
    for (int i = 0; i < 2; ++i) { int R, C; stage_rc(tid * 16 + i * 8192, R, C); const int Rb = Epi::PERM ? ((R & ~31) + perm32(R & 31)) : R;
        voffA[i] = (unsigned)(R * K + C) * 2u; voffB[i] = (unsigned)(Rb * K + C) * 2u; }
    const size_t kstep = (size_t)(BK * 2);
    constexpr int MT = Epi::MT, HA = 32 * MT;
    const size_t hstepA = (size_t)HA * K * 2, hstep = (size_t)HALF * K * 2;
    const size_t tstepA = 2 * hstepA, tstep = 2 * hstep;
    const unsigned ldsw = (unsigned)wid * 1024u;
    const int aoff = lds_byte(wr * (16 * MT) + fr, fq * 8), boff = lds_byte(wc * 32 + fr, fq * 8);
#define PG8_SA(b, h) (((b) * 2 + (h)) * HTB)
#define PG8_SB(b, h) ((4 + (b) * 2 + (h)) * HTB)
#define PG8_STAGE(bufoff, gbase, voff) do { _Pragma("unroll") for (int _i = 0; _i < 2; ++_i) \
        __builtin_amdgcn_global_load_lds((const unsigned*)((const char*)(gbase) + (voff)[_i]), (PG8_LAS unsigned*)(lds + (bufoff) + ldsw + _i * 8192), 16, 0, 0); } while (0)
#define PG8_LDA(dst, b, h) do { _Pragma("unroll") for (int m = 0; m < MT; ++m) _Pragma("unroll") for (int k = 0; k < 2; ++k) dst[m][k] = *(const PG8_LAS bf16x8*)(lds + PG8_SA(b, h) + aoff + m * 2048 + k * 1024); } while (0)
#define PG8_LDB(dst, b, h) do { _Pragma("unroll") for (int n = 0; n < 2; ++n) _Pragma("unroll") for (int k = 0; k < 2; ++k) dst[n][k] = *(const PG8_LAS bf16x8*)(lds + PG8_SB(b, h) + boff + n * 2048 + k * 1024); } while (0)
#define PG8_MMA(ai, bj, At, Bt) do { __builtin_amdgcn_s_setprio(1); _Pragma("unroll") for (int m = 0; m < MT; ++m) _Pragma("unroll") for (int n = 0; n < 2; ++n) _Pragma("unroll") for (int k = 0; k < 2; ++k) \
        acc[ai][bj][m][n] = __builtin_amdgcn_mfma_f32_16x16x32_bf16(Bt[n][k], At[m][k], acc[ai][bj][m][n], 0, 0, 0); __builtin_amdgcn_s_setprio(0); } while (0)
#define PG8_WAIT_V(n) asm volatile("s_waitcnt vmcnt(" #n ")" ::: "memory")
#define PG8_WAIT_L(n) asm volatile("s_waitcnt lgkmcnt(" #n ")" ::: "memory")
#define PG8_BAR __builtin_amdgcn_s_barrier()
#define PG8_SCHED __builtin_amdgcn_sched_barrier(0)
    Unit cur, nxt; int ui = 0;
    if (!S.next(0, cur)) return;
    f32x4 acc[2][2][MT][2];
#pragma unroll
    for (int a = 0; a < 2; ++a)
#pragma unroll
        for (int b = 0; b < 2; ++b)
#pragma unroll
            for (int m = 0; m < MT; ++m)
#pragma unroll
                for (int n = 0; n < 2; ++n) acc[a][b][m][n] = (f32x4){0.f, 0.f, 0.f, 0.f};
    bf16x8 At[MT][2], B0[2][2], B1[2][2];
    const char* cA = (const char*)g.A + (size_t)cur.pm * tstepA; const char* cB = (const char*)g.Bt + (size_t)cur.pn * tstep;
    S.a_ready(cur);
    if constexpr (SP2) {
        PG8_STAGE(PG8_SB(0, 0), cB, voffB); PG8_STAGE(PG8_SB(0, 1), cB + hstep, voffB); PG8_STAGE(PG8_SA(0, 0), cA, voffA); PG8_STAGE(PG8_SA(0, 1), cA + hstepA, voffA);
        if (wr == 1) PG8_BAR;
        PG8_WAIT_V(2); PG8_BAR;
        PG8_STAGE(PG8_SB(1, 0), cB + kstep, voffB); PG8_STAGE(PG8_SA(1, 0), cA + kstep, voffA); PG8_STAGE(PG8_SB(1, 1), cB + hstep + kstep, voffB);
        PG8_WAIT_V(6); PG8_BAR;
    } else {
        PG8_STAGE(PG8_SB(0, 0), cB, voffB); PG8_STAGE(PG8_SA(0, 0), cA, voffA); PG8_STAGE(PG8_SB(0, 1), cB + hstep, voffB); PG8_STAGE(PG8_SA(0, 1), cA + hstepA, voffA);
        if (wr == 1) PG8_BAR;
        PG8_WAIT_V(4); PG8_BAR;
        PG8_STAGE(PG8_SB(1, 0), cB + kstep, voffB); PG8_STAGE(PG8_SA(1, 0), cA + kstep, voffA); PG8_STAGE(PG8_SB(1, 1), cB + hstep + kstep, voffB);
        PG8_WAIT_V(6); PG8_BAR;
    }
    for (;;) {
        const bool has_next = S.next(ui + 1, nxt);
        const char* nA = has_next ? (const char*)g.A + (size_t)nxt.pm * tstepA : cA; const char* nB = has_next ? (const char*)g.Bt + (size_t)nxt.pn * tstep : cB;
        for (int t = 0; t < nt; t += 2) {
            const bool last = (t == nt - 2);
            const char* a1 = cA + (size_t)(t + 1) * kstep;
            const char* a2 = last ? nA : cA + (size_t)(t + 2) * kstep; const char* b2 = last ? nB : cB + (size_t)(t + 2) * kstep;
            const char* a3 = a2 + kstep; const char* b3 = b2 + kstep;
            if (last && has_next) S.a_ready(nxt);
            if constexpr (SP2) {
            PG8_LDB(B0, 0, 0); PG8_LDB(B1, 0, 1); PG8_SCHED; PG8_LDA(At, 0, 0); PG8_STAGE(PG8_SA(1, 1), a1 + hstepA, voffA);
            PG8_WAIT_V(8); PG8_WAIT_L(0); PG8_BAR; PG8_MMA(0, 0, At, B0); PG8_MMA(0, 1, At, B1); PG8_BAR; PG8_SCHED;
            PG8_LDA(At, 0, 1); PG8_STAGE(PG8_SB(0, 0), b2, voffB); PG8_STAGE(PG8_SB(0, 1), b2 + hstep, voffB); PG8_STAGE(PG8_SA(0, 0), a2, voffA);
            PG8_WAIT_V(8); PG8_WAIT_L(0); PG8_BAR; PG8_MMA(1, 0, At, B0); PG8_MMA(1, 1, At, B1); PG8_BAR; PG8_SCHED;
            PG8_LDB(B0, 1, 0); PG8_LDB(B1, 1, 1); PG8_SCHED; PG8_LDA(At, 1, 0); PG8_STAGE(PG8_SA(0, 1), a2 + hstepA, voffA);
            PG8_WAIT_V(8); PG8_WAIT_L(0); PG8_BAR; PG8_MMA(0, 0, At, B0); PG8_MMA(0, 1, At, B1); PG8_BAR; PG8_SCHED;
            PG8_LDA(At, 1, 1); PG8_STAGE(PG8_SB(1, 0), b3, voffB); PG8_STAGE(PG8_SB(1, 1), b3 + hstep, voffB); PG8_STAGE(PG8_SA(1, 0), a3, voffA);
            PG8_WAIT_V(8); PG8_WAIT_L(0); PG8_BAR; PG8_MMA(1, 0, At, B0); PG8_MMA(1, 1, At, B1); PG8_BAR; PG8_SCHED;
            } else {
            PG8_LDB(B0, 0, 0); PG8_SCHED; PG8_LDA(At, 0, 0); PG8_STAGE(PG8_SA(1, 1), a1 + hstepA, voffA);
            PG8_WAIT_L(8); PG8_BAR; PG8_WAIT_L(0); PG8_MMA(0, 0, At, B0); PG8_BAR; PG8_SCHED;
            PG8_LDB(B1, 0, 1); PG8_STAGE(PG8_SB(0, 0), b2, voffB);
            PG8_BAR; PG8_WAIT_L(0); PG8_MMA(0, 1, At, B1); PG8_BAR;
            PG8_LDA(At, 0, 1); PG8_STAGE(PG8_SA(0, 0), a2, voffA);
            PG8_BAR; PG8_WAIT_L(0); PG8_MMA(1, 0, At, B0); PG8_BAR; PG8_SCHED;
            PG8_STAGE(PG8_SB(0, 1), b2 + hstep, voffB);
            PG8_WAIT_V(6); PG8_BAR; PG8_MMA(1, 1, At, B1); PG8_BAR;
            PG8_LDB(B0, 1, 0); PG8_SCHED; PG8_LDA(At, 1, 0); PG8_STAGE(PG8_SA(0, 1), a2 + hstepA, voffA);
            PG8_WAIT_L(8); PG8_BAR; PG8_WAIT_L(0); PG8_MMA(0, 0, At, B0); PG8_BAR; PG8_SCHED;
            PG8_LDB(B1, 1, 1); PG8_STAGE(PG8_SB(1, 0), b3, voffB);
            PG8_BAR; PG8_WAIT_L(0); PG8_MMA(0, 1, At, B1); PG8_BAR;
            PG8_LDA(At, 1, 1); PG8_STAGE(PG8_SA(1, 0), a3, voffA);
            PG8_BAR; PG8_WAIT_L(0); PG8_MMA(1, 0, At, B0); PG8_BAR; PG8_SCHED;
            PG8_STAGE(PG8_SB(1, 1), b3 + hstep, voffB);
            PG8_WAIT_V(6); PG8_BAR; PG8_MMA(1, 1, At, B1); PG8_BAR;
            }
        }
        if constexpr (ALIGN_EPI) { if (wr == 0) PG8_BAR; }
        if constexpr (!Epi::AFTER_DRAIN) { E(acc, cur, wr, wc, fr, fq); S.done(cur); }
        if (!has_next) break;
#pragma unroll
        for (int a = 0; a < 2; ++a)
#pragma unroll
            for (int b = 0; b < 2; ++b)
#pragma unroll
                for (int m = 0; m < MT; ++m)
#pragma unroll
                    for (int n = 0; n < 2; ++n) acc[a][b][m][n] = (f32x4){0.f, 0.f, 0.f, 0.f};
        cur = nxt; cA = nA; cB = nB; ++ui;
        if constexpr (ALIGN_EPI) { if (wr == 1) PG8_BAR; }
    }
    PG8_WAIT_V(0);
    if constexpr (!ALIGN_EPI) { if (wr == 0) PG8_BAR; }
    PG8_BAR;
    if constexpr (Epi::AFTER_DRAIN) { E.fused(acc, cur, wr, wc, fr, fq, lds, wid, lane); S.done(cur); }
#undef PG8_SA
#undef PG8_SB
#undef PG8_STAGE
#undef PG8_LDA
#undef PG8_LDB
#undef PG8_MMA
#undef PG8_WAIT_V
#undef PG8_WAIT_L
#undef PG8_BAR
#undef PG8_SCHED
}
constexpr int TOK_CTX = 4096, TOK_ALL = 12288, PITCH_P = 2304;
constexpr float RMS_EPS_F = 1e-6f;
constexpr float QSCALE = 0.125f * 1.4426950408889634f;
__device__ __forceinline__ u32x4 pack8(const f32x4 a, const f32x4 b) { u32x4 w; w.x = cvt_pk_bf16(a[0], a[1]); w.y = cvt_pk_bf16(a[2], a[3]); w.z = cvt_pk_bf16(b[0], b[1]); w.w = cvt_pk_bf16(b[2], b[3]); return w; }
__device__ __forceinline__ unsigned short bf1(float f) { return (unsigned short)(cvt_pk_bf16(f, 0.f) & 0xffffu); }

struct EpiIn {
    static constexpr bool PERM = true, AFTER_DRAIN = false; static constexpr int MT = 4;
    bf16_t* P; bf16_t* Kl; bf16_t* Vl; bf16_t* Kc; bf16_t* Vc; float* newk; float* newv; const float* qn; const float* kn; const float* rope;
    __device__ __forceinline__ void operator()(const f32x4 (&acc)[2][2][4][2], const Unit& u, int wr, int wc, int fr, int fq) const {
        const int row0 = u.pm * BM + wr * 64 + fr;
        if (u.pn >= 3) {
            const int col0 = u.pn * BM + wc * 32 + 8 * fq;
#pragma unroll
            for (int ai = 0; ai < 2; ++ai)
#pragma unroll
                for (int m = 0; m < 4; ++m) { bf16_t* rowp = P + (size_t)(row0 + ai * HALF + m * 16) * PITCH_P + col0;
#pragma unroll
                    for (int bj = 0; bj < 2; ++bj) *(u32x4*)(rowp + bj * HALF) = pack8(acc[ai][bj][m][0], acc[ai][bj][m][1]); }
            return;
        }
        const int head = 4 * u.pn + wc;
        const bool lat = u.pm >= 16;
        if (head < 10) {
            const float* gsrc = head < 8 ? qn : kn;
            const float oscale = head < 8 ? QSCALE : 1.0f;
            f32x4 g[2][2];
#pragma unroll
            for (int bj = 0; bj < 2; ++bj)
#pragma unroll
                for (int n = 0; n < 2; ++n) g[bj][n] = *(const f32x4*)(gsrc + 32 * bj + 8 * fq + 4 * n);
            const float sgn = (fq & 2) ? 1.0f : -1.0f;
#pragma unroll
            for (int ai = 0; ai < 2; ++ai)
#pragma unroll
                for (int m = 0; m < 4; ++m) {
                    const int r = row0 + ai * HALF + m * 16;
                    float ss = 0.f;
#pragma unroll
                    for (int bj = 0; bj < 2; ++bj)
#pragma unroll
                        for (int n = 0; n < 2; ++n) { const f32x4 x = acc[ai][bj][m][n]; ss += (x[0] * x[0] + x[1] * x[1]) + (x[2] * x[2] + x[3] * x[3]); }
                    ss += __shfl_xor(ss, 16); ss += __shfl_xor(ss, 32);
                    const float rinv = 1.0f / sqrtf(ss * (1.0f / 64.0f) + RMS_EPS_F);
                    f32x4 v[2][2];
#pragma unroll
                    for (int bj = 0; bj < 2; ++bj)
#pragma unroll
                        for (int n = 0; n < 2; ++n) v[bj][n] = acc[ai][bj][m][n] * rinv * g[bj][n];
                    if (!lat && head >= 8) {
                        float* nk = newk + ((size_t)r * 2 + (head - 8)) * 64 + 8 * fq;
#pragma unroll
                        for (int bj = 0; bj < 2; ++bj)
#pragma unroll
                            for (int n = 0; n < 2; ++n) *(f32x4*)(nk + 32 * bj + 4 * n) = v[bj][n];
                    }
                    if (lat) {
                        const int s = (r - TOK_CTX) & 1023;
#pragma unroll
                        for (int bj = 0; bj < 2; ++bj) {
                            const int pos = bj == 0 ? (s >> 6) : (s & 63);
#pragma unroll
                            for (int n = 0; n < 2; ++n) {
                                const f32x4 cs = *(const f32x4*)(rope + pos * 16 + 8 * (fq & 1) + 4 * n);
                                const f32x4 sn = *(const f32x4*)(rope + 1024 + pos * 16 + 8 * (fq & 1) + 4 * n);
                                f32x4 pt;
#pragma unroll
                                for (int j = 0; j < 4; ++j) pt[j] = __shfl_xor(v[bj][n][j], 32);
                                v[bj][n] = v[bj][n] * cs + pt * (sn * sgn);
                            }
                        }
                    }
                    bf16_t* dst;
                    if (head < 8) dst = P + (size_t)r * PITCH_P + head * 64 + 8 * fq;
                    else if (lat) { const int b = (r - TOK_CTX) >> 10, s = (r - TOK_CTX) & 1023; dst = Kl + ((size_t)(b * 2 + (head - 8)) * 1280 + 256 + s) * 64 + 8 * fq; }
                    else { const int b = r >> 8, s = r & 255; dst = Kc + ((size_t)(b * 2 + (head - 8)) * 256 + s) * 64 + 8 * fq; }
#pragma unroll
                    for (int bj = 0; bj < 2; ++bj) *(u32x4*)(dst + 32 * bj) = pack8(v[bj][0] * oscale, v[bj][1] * oscale);
                }
        } else {
            const int kvh = head - 10;
#pragma unroll
            for (int ai = 0; ai < 2; ++ai)
#pragma unroll
                for (int m = 0; m < 4; ++m) {
                    const int r = row0 + ai * HALF + m * 16;
                    bf16_t* vt; int T;
                    if (lat) { const int b = (r - TOK_CTX) >> 10, s = (r - TOK_CTX) & 1023; T = 1280; vt = Vl + (size_t)(b * 2 + kvh) * 64 * 1280 + 256 + s; }
                    else { const int b = r >> 8, s = r & 255; T = 256; vt = Vc + (size_t)(b * 2 + kvh) * 64 * 256 + s;
                        float* nv = newv + ((size_t)r * 2 + kvh) * 64 + 8 * fq;
#pragma unroll
                        for (int bj = 0; bj < 2; ++bj)
#pragma unroll
                            for (int n = 0; n < 2; ++n) *(f32x4*)(nv + 32 * bj + 4 * n) = acc[ai][bj][m][n]; }
#pragma unroll
                    for (int bj = 0; bj < 2; ++bj)
#pragma unroll
                        for (int n = 0; n < 2; ++n)
#pragma unroll
                            for (int j = 0; j < 4; ++j) vt[(size_t)(32 * bj + 8 * fq + 4 * n + j) * T] = bf1(acc[ai][bj][m][n][j]);
                }
        }
    }
};

struct EpiRes {
    static constexpr bool PERM = false, AFTER_DRAIN = false; static constexpr int MT = 4;
    const float* xa; const float* xb; float* out; const float* gate;
    __device__ __forceinline__ void operator()(const f32x4 (&acc)[2][2][4][2], const Unit& u, int wr, int wc, int fr, int fq) const {
        const int row0 = u.pm * BM + wr * 64 + fr, col0 = u.pn * BM + wc * 32 + 4 * fq;
        const int mrow = u.pm < 16 ? 8 : ((u.pm - 16) >> 2);
        f32x4 g[2][2];
#pragma unroll
        for (int bj = 0; bj < 2; ++bj)
#pragma unroll
            for (int n = 0; n < 2; ++n) g[bj][n] = *(const f32x4*)(gate + (size_t)mrow * 6144 + col0 + bj * HALF + n * 16);
#pragma unroll
        for (int ai = 0; ai < 2; ++ai)
#pragma unroll
            for (int m = 0; m < 4; ++m) {
                const int r = row0 + ai * HALF + m * 16;
                const float* bp = (r < TOK_CTX ? xa + (size_t)r * 1024 : xb + (size_t)(r - TOK_CTX) * 1024) + col0;
                float* op = out + (size_t)r * 1024 + col0;
#pragma unroll
                for (int bj = 0; bj < 2; ++bj)
#pragma unroll
                    for (int n = 0; n < 2; ++n) { const f32x4 b = *(const f32x4*)(bp + bj * HALF + n * 16); *(f32x4*)(op + bj * HALF + n * 16) = b + g[bj][n] * acc[ai][bj][m][n]; }
            }
    }
};

struct EpiSwiGLU {
    static constexpr bool PERM = true, AFTER_DRAIN = false; static constexpr int MT = 4;
    bf16_t* act; int ldc;
    __device__ __forceinline__ void operator()(const f32x4 (&acc)[2][2][4][2], const Unit& u, int wr, int wc, int fr, int fq) const {
        const int row0 = u.pm * BM + wr * 64 + fr, col0 = u.pn * HALF + wc * 32 + 8 * fq;
#pragma unroll
        for (int ai = 0; ai < 2; ++ai)
#pragma unroll
            for (int m = 0; m < 4; ++m) {
                f32x4 o[2];
#pragma unroll
                for (int n = 0; n < 2; ++n) {
                    const f32x4 gt = acc[ai][0][m][n], up = acc[ai][1][m][n];
#pragma unroll
                    for (int j = 0; j < 4; ++j) { const float e = __builtin_amdgcn_exp2f(gt[j] * -1.4426950408889634f); o[n][j] = gt[j] * __builtin_amdgcn_rcpf(1.0f + e) * up[j]; }
                }
                *(u32x4*)(act + (size_t)(row0 + ai * HALF + m * 16) * ldc + col0) = pack8(o[0], o[1]);
            }
    }
};

struct EpiRes3 {
    static constexpr bool PERM = false, AFTER_DRAIN = false; static constexpr int MT = 3;
    const float* xa; const float* xb; float* out; const float* gate;
    __device__ __forceinline__ void operator()(const f32x4 (&acc)[2][2][3][2], const Unit& u, int wr, int wc, int fr, int fq) const {
        const int col0 = u.pn * BM + wc * 32 + 4 * fq;
#pragma unroll
        for (int ai = 0; ai < 2; ++ai)
#pragma unroll
            for (int m = 0; m < 3; ++m) {
                const int rg = u.pm * 192 + ai * 96 + wr * 48 + m * 16, r = rg + fr;
                const int mrow = rg < TOK_CTX ? 8 : ((rg - TOK_CTX) >> 10);
                const float* gp = gate + (size_t)mrow * 6144 + col0;
                const float* bp = (r < TOK_CTX ? xa + (size_t)r * 1024 : xb + (size_t)(r - TOK_CTX) * 1024) + col0;
                float* op = out + (size_t)r * 1024 + col0;
#pragma unroll
                for (int bj = 0; bj < 2; ++bj)
#pragma unroll
                    for (int n = 0; n < 2; ++n) { const f32x4 b = *(const f32x4*)(bp + bj * HALF + n * 16), g = *(const f32x4*)(gp + bj * HALF + n * 16); *(f32x4*)(op + bj * HALF + n * 16) = b + g * acc[ai][bj][m][n]; }
            }
    }
};
struct EpiSwiGLU3 {
    static constexpr bool PERM = true, AFTER_DRAIN = false; static constexpr int MT = 3;
    bf16_t* act; int ldc; int row_base;
    __device__ __forceinline__ void operator()(const f32x4 (&acc)[2][2][3][2], const Unit& u, int wr, int wc, int fr, int fq) const {
        const int col0 = u.pn * HALF + wc * 32 + 8 * fq;
#pragma unroll
        for (int ai = 0; ai < 2; ++ai)
#pragma unroll
            for (int m = 0; m < 3; ++m) {
                const int r = row_base + u.pm * 192 + ai * 96 + wr * 48 + m * 16 + fr;
                f32x4 o[2];
#pragma unroll
                for (int n = 0; n < 2; ++n) {
                    const f32x4 gt = acc[ai][0][m][n], up = acc[ai][1][m][n];
#pragma unroll
                    for (int j = 0; j < 4; ++j) { const float e = __builtin_amdgcn_exp2f(gt[j] * -1.4426950408889634f); o[n][j] = gt[j] * __builtin_amdgcn_rcpf(1.0f + e) * up[j]; }
                }
                *(u32x4*)(act + (size_t)r * ldc + col0) = pack8(o[0], o[1]);
            }
    }
};
}
#define GAS __attribute__((address_space(1)))
#define LAS __attribute__((address_space(3)))
typedef unsigned short bf16;
typedef unsigned v4u __attribute__((ext_vector_type(4)));
typedef float f32x4 __attribute__((ext_vector_type(4)));
typedef float f32x16 __attribute__((ext_vector_type(16)));
typedef short bf16x8 __attribute__((ext_vector_type(8)));
constexpr int NWAVES = 8, NTHREADS = 512;
constexpr int D = 1024, M_CTX = 4096, M_ALL = 12288, IN_DIM = 2304, D_FF = 2816, NGU = 5632, MODW = 6144;
constexpr size_t MiB = 1u << 20;
constexpr size_t WS_MOD = 1 * MiB, WS_ROPE = 1 * MiB + 512 * 1024, WS_WIN = 2 * MiB, WS_WOUT = 7 * MiB, WS_WGU = 9 * MiB, WS_WDN = 20 * MiB;
constexpr size_t WS_KL = 26 * MiB, WS_VL = 29 * MiB, WS_KC = 32 * MiB, WS_VC = 33 * MiB, WS_H = 34 * MiB, WS_P = 58 * MiB, WS_MRG = 34 * MiB  , WS_ACT = 58 * MiB  , WS_END = 124 * MiB;
constexpr int RING_BYTES = 131072, LDS_BYTES = 147456;

__device__ __forceinline__ unsigned f2bf(float f) { unsigned u = __builtin_bit_cast(unsigned, f); return (u + 0x7fffu + ((u >> 16) & 1u)) >> 16; }
__device__ __forceinline__ unsigned pk2(float lo, float hi) { return f2bf(lo) | (f2bf(hi) << 16); }
__device__ __forceinline__ float bf2f(unsigned short h) { return __builtin_bit_cast(float, (unsigned)h << 16); }
__device__ __forceinline__ float wave_sum(float v) {
#pragma unroll
    for (int o = 1; o < 64; o <<= 1) v += __shfl_xor(v, o);
    return v;
}
#define LDS_WAIT() asm volatile("s_waitcnt lgkmcnt(0)" ::: "memory")

struct Args {
    const float* xp; const float* xs; const float* c; const float* cache_k; const float* cache_v; const float* c_ctx; const float* norm_mix; const float* norm_ffn;
    const float* w_ada; const float* b_ada; const float* w_in; const float* q_norm; const float* k_norm; const float* conv_w; const float* aon; const float* con;
    const float* w_out; const float* w_gu; const float* w_dn; float* out; unsigned char* ws; int ph_lo, ph_hi, li, pad;
};

__device__ __forceinline__ void transpose_item(const float* W, int ldw, int src0, int K, int k0, bf16* WT, int dst0, const float* kgain, LAS float* scr, int lane) {
#pragma unroll
    for (int i = 0; i < 32; ++i) { const int kk = 2 * i + (lane >> 5); float w = W[(size_t)(k0 + kk) * ldw + src0 + (lane & 31)]; if (kgain) w *= kgain[k0 + kk]; scr[kk * 33 + (lane & 31)] = w; }
    LDS_WAIT(); asm volatile("" ::: "memory");
    const int c = lane & 7;
#pragma unroll
    for (int j = 0; j < 4; ++j) { const int n = (lane >> 3) + 8 * j; const LAS float* s = scr + (8 * c) * 33 + n;
        v4u o; o.x = pk2(s[0 * 33], s[1 * 33]); o.y = pk2(s[2 * 33], s[3 * 33]); o.z = pk2(s[4 * 33], s[5 * 33]); o.w = pk2(s[6 * 33], s[7 * 33]);
        *(v4u*)(WT + (size_t)(dst0 + n) * K + k0 + 8 * c) = o; }
    LDS_WAIT(); asm volatile("" ::: "memory");
}

struct TrItem { const float* W; int ldw, src0, K, k0; bf16* WT; int dst0; const float* gain; };
__device__ __forceinline__ void tr_load(const TrItem& t, float (&w)[32], int lane) {
#pragma unroll
    for (int i = 0; i < 32; ++i) { const int kk = 2 * i + (lane >> 5); w[i] = t.W[(size_t)(t.k0 + kk) * t.ldw + t.src0 + (lane & 31)]; }
}
__device__ __forceinline__ void tr_store(const TrItem& t, const float (&w)[32], LAS float* scr, int lane) {
#pragma unroll
    for (int i = 0; i < 32; ++i) { const int kk = 2 * i + (lane >> 5); scr[kk * 33 + (lane & 31)] = t.gain ? w[i] * t.gain[t.k0 + kk] : w[i]; }
    LDS_WAIT(); asm volatile("" ::: "memory");
    const int c = lane & 7;
#pragma unroll
    for (int j = 0; j < 4; ++j) { const int n = (lane >> 3) + 8 * j; const LAS float* s = scr + (8 * c) * 33 + n;
        v4u o; o.x = pk2(s[0 * 33], s[1 * 33]); o.y = pk2(s[2 * 33], s[3 * 33]); o.z = pk2(s[4 * 33], s[5 * 33]); o.w = pk2(s[6 * 33], s[7 * 33]);
        *(v4u*)(t.WT + (size_t)(t.dst0 + n) * t.K + t.k0 + 8 * c) = o; }
    LDS_WAIT(); asm volatile("" ::: "memory");
}

__device__ __forceinline__ void norm_rows2(const float* x0, const float* x1, const float* nw, const float* sc0, const float* sh0, const float* sc1, const float* sh1, bf16* o0, bf16* o1, int lane) {
    const f32x4* xr0 = (const f32x4*)x0 + lane; const f32x4* xr1 = (const f32x4*)x1 + lane;
    f32x4 v0[4], v1[4]; float s0 = 0.f, s1 = 0.f;
#pragma unroll
    for (int j = 0; j < 4; ++j) { v0[j] = xr0[64 * j]; v1[j] = xr1[64 * j]; }
#pragma unroll
    for (int j = 0; j < 4; ++j) { s0 += (v0[j].x * v0[j].x + v0[j].y * v0[j].y) + (v0[j].z * v0[j].z + v0[j].w * v0[j].w); s1 += (v1[j].x * v1[j].x + v1[j].y * v1[j].y) + (v1[j].z * v1[j].z + v1[j].w * v1[j].w); }
#pragma unroll
    for (int o = 1; o < 64; o <<= 1) { s0 += __shfl_xor(s0, o); s1 += __shfl_xor(s1, o); }
    const float r0 = 1.0f / sqrtf(s0 * (1.0f / 1024.0f) + 1e-6f), r1 = 1.0f / sqrtf(s1 * (1.0f / 1024.0f) + 1e-6f);
    unsigned long long* p0 = (unsigned long long*)o0 + lane; unsigned long long* p1 = (unsigned long long*)o1 + lane;
#pragma unroll
    for (int j = 0; j < 4; ++j) {
        const f32x4 w = ((const f32x4*)nw)[lane + 64 * j];
        const f32x4 a0 = ((const f32x4*)sc0)[lane + 64 * j], b0 = ((const f32x4*)sh0)[lane + 64 * j], a1 = ((const f32x4*)sc1)[lane + 64 * j], b1 = ((const f32x4*)sh1)[lane + 64 * j];
        const f32x4 y0 = v0[j] * r0 * w * (a0 + 1.0f) + b0, y1 = v1[j] * r1 * w * (a1 + 1.0f) + b1;
        p0[64 * j] = (unsigned long long)pk2(y0.x, y0.y) | ((unsigned long long)pk2(y0.z, y0.w) << 32);
        p1[64 * j] = (unsigned long long)pk2(y1.x, y1.y) | ((unsigned long long)pk2(y1.z, y1.w) << 32);
    }
}

constexpr int KVP = 144, KT_BYTES = 2 * 64 * KVP, BUF_BYTES = 2 * KT_BYTES;
constexpr int ATT_SC = 2 * BUF_BYTES, ATT_XS = ATT_SC + 8 * 64 * 4, OSP = 68;
__device__ __forceinline__ int crow(int r, int hi) { return (r & 3) + 8 * (r >> 2) + 4 * hi; }
__device__ __forceinline__ unsigned cvtpk(float lo, float hi) { return pg8::cvt_pk_bf16(lo, hi); }

#define ATT_THR 6.0f
__device__ __forceinline__ float max3f(float a, float b, float c) { float r; asm("v_max3_f32 %0, %1, %2, %3" : "=v"(r) : "v"(a), "v"(b), "v"(c)); return r; }
__device__ __forceinline__ float rowmax32(const f32x16& a, const f32x16& b) {
    float t[16];
#pragma unroll
    for (int r = 0; r < 16; ++r) t[r] = fmaxf(a[r], b[r]);
    float m0 = max3f(t[0], t[1], t[2]), m1 = max3f(t[3], t[4], t[5]);
    m0 = max3f(m0, t[6], t[7]); m1 = max3f(m1, t[8], t[9]); m0 = max3f(m0, t[10], t[11]); m1 = max3f(m1, t[12], t[13]); m0 = max3f(m0, t[14], t[15]);
    return fmaxf(m0, m1);
}
constexpr int ATT_SLOT = 16384, ATT_KR = 0, ATT_VR = 3 * ATT_SLOT, ATT_SC2 = 6 * ATT_SLOT, ATT_XS2 = ATT_SC2 + 8 * 64 * 4;
__device__ __forceinline__ void attn_unit(LAS unsigned char* lds, const bf16* Pq, int m0, const bf16* Kb, const bf16* Vb, int T, bf16* mrg) {
    const int tid = threadIdx.x, lane = tid & 63, r32 = lane & 31, hi = lane >> 5, wid = __builtin_amdgcn_readfirstlane(tid >> 6), kvh = wid >> 2;
    bf16x8 qr[4];
    { const bf16* qp = Pq + (size_t)(m0 + r32) * IN_DIM + wid * 64 + hi * 8;
#pragma unroll
      for (int d0 = 0; d0 < 4; ++d0) qr[d0] = *(const bf16x8*)(qp + d0 * 16); }
    const bf16* ksrc[2]; const bf16* vsrc[2];
#pragma unroll
    for (int i = 0; i < 2; ++i) { const int j = wid + 8 * i, kh = j >> 3, row = 8 * (j & 7) + (lane >> 3), c = (lane & 7) ^ ((row >> 1) & 7);
        ksrc[i] = Kb + ((size_t)(kh * T + row)) * 64 + c * 8; vsrc[i] = Vb + ((size_t)(kh * 64 + row)) * T + c * 8; }
    const int NT = T >> 6;
#define DMA_K(tk, sk) do { _Pragma("unroll") for (int i = 0; i < 2; ++i) \
        __builtin_amdgcn_global_load_lds((const unsigned*)(ksrc[i] + (size_t)(tk) * 64 * 64), (LAS unsigned*)(lds + ATT_KR + (sk) * ATT_SLOT + (wid + 8 * i) * 1024), 16, 0, 0); } while (0)
#define DMA_V(tv, sv) do { _Pragma("unroll") for (int i = 0; i < 2; ++i) \
        __builtin_amdgcn_global_load_lds((const unsigned*)(vsrc[i] + (tv) * 64), (LAS unsigned*)(lds + ATT_VR + (sv) * ATT_SLOT + (wid + 8 * i) * 1024), 16, 0, 0); } while (0)
#define DMA_KV(tk, sk, tv, sv) do { DMA_K(tk, sk); DMA_V(tv, sv); } while (0)
    DMA_KV(0, 0, 0, 0); DMA_KV(1, 1, 0, 0); DMA_KV(2, 2, 1, 1);
    const int pr = (r32 & ~12) | ((r32 & 4) << 1) | ((r32 & 8) >> 1);
    int koffs[4], voffs[4];
#pragma unroll
    for (int d0 = 0; d0 < 4; ++d0) { koffs[d0] = kvh * 8192 + pr * 128 + (((2 * d0 + hi) ^ ((pr >> 1) & 7)) << 4); voffs[d0] = kvh * 8192 + r32 * 128 + (((2 * d0 + hi) ^ ((r32 >> 1) & 7)) << 4); }
    LAS float* sc = (LAS float*)(lds + ATT_SC2) + wid * 64;
    const unsigned ldsb = (unsigned)(uintptr_t)lds;
#define DSR(dst, addr, off) asm volatile("ds_read_b128 %0, %1 offset:%2" : "=v"(dst) : "v"(addr), "i"(off) : "memory")
    asm volatile("s_waitcnt vmcnt(4)" ::: "memory"); __builtin_amdgcn_s_barrier(); asm volatile("" ::: "memory");
    f32x16 o0 = {}, o1 = {}, o2 = {};
    const bf16x8 ones = {16256, 16256, 16256, 16256, 16256, 16256, 16256, 16256};
    f32x16 c0 = {}, c1 = {}, n0, n1;
#pragma unroll
    for (int d0 = 0; d0 < 4; ++d0) {
        const bf16x8 k0 = *(const LAS bf16x8*)(lds + ATT_KR + koffs[d0]), k1 = *(const LAS bf16x8*)(lds + ATT_KR + koffs[d0] + 32 * 128);
        c0 = __builtin_amdgcn_mfma_f32_32x32x16_bf16(k0, qr[d0], c0, 0, 0, 0);
        c1 = __builtin_amdgcn_mfma_f32_32x32x16_bf16(k1, qr[d0], c1, 0, 0, 0);
    }
    asm volatile("s_waitcnt lgkmcnt(0)" ::: "memory"); __builtin_amdgcn_s_barrier(); asm volatile("" ::: "memory");
    float mrun = rowmax32(c0, c1), rmc = 0.f; mrun = fmaxf(mrun, __shfl_xor(mrun, 32));
#pragma unroll
    for (int r = 0; r < 16; ++r) { c0[r] -= mrun; c1[r] -= mrun; }
    int sk1 = 1, sv0 = 0;
#define ATT_ITER(t, MORE, C0, C1, N0, N1) do { \
        const bool dk_ = (t) + 3 < NT, dv_ = (t) + 2 < NT;       \
        { const int skn_ = sk1 == 0 ? 2 : sk1 - 1, svn_ = sv0 == 0 ? 2 : sv0 - 1; if (dk_) DMA_K((t) + 3, skn_); if (dv_) DMA_V((t) + 2, svn_); } \
        if (__any(rmc > ATT_THR)) { \
            const float rmf_ = fmaxf(rmc, __shfl_xor(rmc, 32)); const float dl = fmaxf(rmf_, 0.f), alpha = __builtin_amdgcn_exp2f(-dl); mrun += dl; \
            _Pragma("unroll") for (int r = 0; r < 16; ++r) { C0[r] -= dl; C1[r] -= dl; } \
            if (hi == 0) sc[r32] = alpha; \
            _Pragma("unroll") for (int g = 0; g < 4; ++g) { const f32x4 a4 = *(const LAS f32x4*)(sc + 8 * g + 4 * hi); \
                _Pragma("unroll") for (int i = 0; i < 4; ++i) { o0[4 * g + i] *= a4[i]; o1[4 * g + i] *= a4[i]; o2[4 * g + i] *= a4[i]; } } \
        } \
        bf16x8 kf_[8], vf_[8]; \
        { const unsigned kb_ = ldsb + ATT_KR + sk1 * ATT_SLOT, vb_ = ldsb + ATT_VR + sv0 * ATT_SLOT; \
          if (MORE) { _Pragma("unroll") for (int d0 = 0; d0 < 4; ++d0) { DSR(kf_[2 * d0], kb_ + koffs[d0], 0); DSR(kf_[2 * d0 + 1], kb_ + koffs[d0], 4096); } } \
          _Pragma("unroll") for (int s4 = 0; s4 < 2; ++s4) { DSR(vf_[2 * s4], vb_ + voffs[s4], 0); DSR(vf_[2 * s4 + 1], vb_ + voffs[s4], 4096); } \
          asm volatile("s_waitcnt lgkmcnt(4)" ::: "memory"); __builtin_amdgcn_sched_barrier(0);        \
          _Pragma("unroll") for (int s4 = 2; s4 < 4; ++s4) { DSR(vf_[2 * s4], vb_ + voffs[s4], 0); DSR(vf_[2 * s4 + 1], vb_ + voffs[s4], 4096); } } \
        if (MORE) { f32x16 negm; _Pragma("unroll") for (int r = 0; r < 16; ++r) negm[r] = -mrun; \
              _Pragma("unroll") for (int d0 = 0; d0 < 4; ++d0) { \
              N0 = __builtin_amdgcn_mfma_f32_32x32x16_bf16(kf_[2 * d0], qr[d0], d0 == 0 ? negm : N0, 0, 0, 0); \
              N1 = __builtin_amdgcn_mfma_f32_32x32x16_bf16(kf_[2 * d0 + 1], qr[d0], d0 == 0 ? negm : N1, 0, 0, 0); } } \
        _Pragma("unroll") for (int r = 0; r < 16; ++r) { C0[r] = __builtin_amdgcn_exp2f(C0[r]); C1[r] = __builtin_amdgcn_exp2f(C1[r]); } \
        v4u pw[4]; \
        _Pragma("unroll") for (int s2 = 0; s2 < 2; ++s2) { \
            pw[s2]     = (v4u){cvtpk(C0[8 * s2], C0[8 * s2 + 1]), cvtpk(C0[8 * s2 + 2], C0[8 * s2 + 3]), cvtpk(C0[8 * s2 + 4], C0[8 * s2 + 5]), cvtpk(C0[8 * s2 + 6], C0[8 * s2 + 7])}; \
            pw[2 + s2] = (v4u){cvtpk(C1[8 * s2], C1[8 * s2 + 1]), cvtpk(C1[8 * s2 + 2], C1[8 * s2 + 3]), cvtpk(C1[8 * s2 + 4], C1[8 * s2 + 5]), cvtpk(C1[8 * s2 + 6], C1[8 * s2 + 7])}; } \
        asm volatile("s_waitcnt lgkmcnt(0)" ::: "memory"); __builtin_amdgcn_sched_barrier(0); \
        _Pragma("unroll") for (int s4 = 0; s4 < 4; ++s4) { \
            o0 = __builtin_amdgcn_mfma_f32_32x32x16_bf16(__builtin_bit_cast(bf16x8, pw[s4]), vf_[2 * s4], o0, 0, 0, 0); \
            o1 = __builtin_amdgcn_mfma_f32_32x32x16_bf16(__builtin_bit_cast(bf16x8, pw[s4]), vf_[2 * s4 + 1], o1, 0, 0, 0); \
            o2 = __builtin_amdgcn_mfma_f32_32x32x16_bf16(__builtin_bit_cast(bf16x8, pw[s4]), ones, o2, 0, 0, 0); } \
        rmc = MORE ? rowmax32(N0, N1) : 0.f; \
        sk1 = sk1 == 2 ? 0 : sk1 + 1; sv0 = sv0 == 2 ? 0 : sv0 + 1; \
        if (dk_) asm volatile("s_waitcnt vmcnt(4)" ::: "memory"); else if (dv_) asm volatile("s_waitcnt vmcnt(2)" ::: "memory"); else asm volatile("s_waitcnt vmcnt(0)" ::: "memory");     \
        asm volatile("s_waitcnt lgkmcnt(0)" ::: "memory"); __builtin_amdgcn_s_barrier(); asm volatile("" ::: "memory"); \
    } while (0)
    int t = 0;
    for (; t < NT - 2; t += 2) {
        ATT_ITER(t, true, c0, c1, n0, n1);
        ATT_ITER(t + 1, true, n0, n1, c0, c1);
    }
    ATT_ITER(t, true, c0, c1, n0, n1);
    ATT_ITER(t + 1, false, n0, n1, c0, c1);
#undef ATT_ITER
#undef DMA_KV
#undef DMA_K
#undef DMA_V
#undef DSR
    asm volatile("s_waitcnt vmcnt(0)" ::: "memory"); __builtin_amdgcn_s_barrier(); asm volatile("" ::: "memory");
    LAS float* st = (LAS float*)lds + wid * (32 * OSP);
#pragma unroll
    for (int r = 0; r < 16; ++r) { const float rl = 1.0f / o2[r]; st[crow(r, hi) * OSP + r32] = o0[r] * rl; st[crow(r, hi) * OSP + 32 + r32] = o1[r] * rl; }
    const int q = lane >> 1, hf = lane & 1;
    f32x4 ov[8]; float ss = 0.f;
#pragma unroll
    for (int i = 0; i < 8; ++i) { ov[i] = *(const LAS f32x4*)(st + q * OSP + 32 * hf + 4 * i); ss += (ov[i].x * ov[i].x + ov[i].y * ov[i].y) + (ov[i].z * ov[i].z + ov[i].w * ov[i].w); }
    ss += __shfl_xor(ss, 1);
    LAS float* xs = (LAS float*)(lds + ATT_XS2);
    if (hf == 0) xs[wid * 32 + q] = ss;
    __syncthreads();
    float tot = 0.f;
#pragma unroll
    for (int w = 0; w < 8; ++w) tot += xs[w * 32 + q];
    const float rinv = 1.0f / sqrtf(tot * (1.0f / 512.0f) + 1e-6f);
    bf16* op = mrg + (size_t)(m0 + q) * D + wid * 64 + 32 * hf;
#pragma unroll
    for (int i = 0; i < 4; ++i) { const f32x4 a = ov[2 * i] * rinv, b = ov[2 * i + 1] * rinv; v4u w; w.x = pk2(a.x, a.y); w.y = pk2(a.z, a.w); w.z = pk2(b.x, b.y); w.w = pk2(b.z, b.w); *(v4u*)(op + 8 * i) = w; }
    __syncthreads();
}

__device__ __forceinline__ void unpack8(const v4u v, float (&f)[8]) {
#pragma unroll
    for (int i = 0; i < 4; ++i) { f[2 * i] = __builtin_bit_cast(float, v[i] << 16); f[2 * i + 1] = __builtin_bit_cast(float, v[i] & 0xffff0000u); }
}
__device__ __forceinline__ void conv_run6(const bf16* P, const float* cw, int m0, bf16* mrg, int lane) {
    v4u gcr[8], ur[8], gbr[6];
#pragma unroll
    for (int i = 0; i < 8; ++i) { int m = m0 - 1 + i; m = m < 0 ? 0 : (m > M_ALL - 1 ? M_ALL - 1 : m); const bf16* row = P + (size_t)m * IN_DIM + 8 * lane; gcr[i] = *(const v4u*)(row + 1280); ur[i] = *(const v4u*)(row + 1792); }
#pragma unroll
    for (int i = 0; i < 6; ++i) gbr[i] = *(const v4u*)(P + (size_t)(m0 + i) * IN_DIM + 8 * lane + 768);
    float w0[8], w1[8], w2[8];
#pragma unroll
    for (int i = 0; i < 8; ++i) { w0[i] = cw[8 * lane + i]; w1[i] = cw[512 + 8 * lane + i]; w2[i] = cw[1024 + 8 * lane + i]; }
    float z[8][8];
#pragma unroll
    for (int i = 0; i < 8; ++i) { float a[8], b[8]; unpack8(gcr[i], a); unpack8(ur[i], b);
#pragma unroll
        for (int c = 0; c < 8; ++c) z[i][c] = a[c] * b[c]; }
#pragma unroll
    for (int t = 0; t < 6; ++t) {
        const int m = m0 + t; const int s = m < M_CTX ? (m & 255) : ((m - M_CTX) & 1023), L = m < M_CTX ? 256 : 1024;
        const float fp = s > 0 ? 1.0f : 0.0f, fn = s < L - 1 ? 1.0f : 0.0f;
        float g[8], y[8]; unpack8(gbr[t], g); float ss = 0.f;
#pragma unroll
        for (int c = 0; c < 8; ++c) { y[c] = g[c] * (w0[c] * fp * z[t][c] + w1[c] * z[t + 1][c] + w2[c] * fn * z[t + 2][c]); ss += y[c] * y[c]; }
        const float rinv = 1.0f / sqrtf(wave_sum(ss) * (1.0f / 512.0f) + 1e-6f);
        v4u o; o.x = pk2(y[0] * rinv, y[1] * rinv); o.y = pk2(y[2] * rinv, y[3] * rinv); o.z = pk2(y[4] * rinv, y[5] * rinv); o.w = pk2(y[6] * rinv, y[7] * rinv);
        *(v4u*)(mrg + (size_t)m * D + 512 + 8 * lane) = o;
    }
}

#define XB_TMO      128
#define XB_XCNT(j)  (256  + 64 * (j))
#define XB_XSUB(j)  (1280 + 64 * (j))
#define XB_XGEN(j)  (2304 + 64 * (j))
#define XB_TOP      3328
#define XB_TOPGEN   3392
#define XCD_BAR_WORDS 3456
#define XB_SPIN_CAP (1u << 18)

__device__ __forceinline__ unsigned xb_ld(unsigned* p)              { return __hip_atomic_load(p, __ATOMIC_RELAXED, __HIP_MEMORY_SCOPE_AGENT); }
__device__ __forceinline__ unsigned xb_add(unsigned* p, unsigned v) { return __hip_atomic_fetch_add(p, v, __ATOMIC_RELAXED, __HIP_MEMORY_SCOPE_AGENT); }
__device__ __forceinline__ unsigned xb_xcc_id() { return (unsigned)__builtin_amdgcn_s_getreg((3 << 11) | 20) & 0xFu; }
#define XB_SPIN(cond, bar) do { unsigned _sp = 0; while (cond) { __builtin_amdgcn_s_sleep(1); \
    if ((++_sp & 255u) == 0u) { if (xb_ld(&(bar)[XB_TMO])) break; if (_sp > XB_SPIN_CAP) { atomicAdd(&(bar)[XB_TMO], 1u); break; } } } } while (0)

struct XcdBarrier {
    unsigned* bar; unsigned x;
    volatile LAS unsigned* st;
};

__device__ __forceinline__ XcdBarrier xcd_barrier_post(unsigned* bar, volatile LAS unsigned* st) {
    XcdBarrier b; b.bar = bar; b.x = xb_xcc_id(); b.st = st;
    if (threadIdx.x == 0) (void)xb_add(&bar[XB_XCNT(b.x)], 1u);
    return b;
}
__device__ __forceinline__ void xcd_barrier_complete(unsigned* bar, unsigned x, unsigned& nloc, unsigned& nx) {
    const unsigned G = gridDim.x * gridDim.y * gridDim.z;
    unsigned sum, cnt, mine, sp = 0u;
    for (;;) {
        sum = 0u; cnt = 0u; mine = 0u;
#pragma unroll
        for (unsigned j = 0; j < 16; ++j) { const unsigned c = xb_ld(&bar[XB_XCNT(j)]); sum += c; cnt += (c > 0u) ? 1u : 0u; mine = (j == x) ? c : mine; }
        if (sum == G) break;
        __builtin_amdgcn_s_sleep(1);
        if ((++sp & 255u) == 0u) { if (xb_ld(&bar[XB_TMO])) break; if (sp > XB_SPIN_CAP) { atomicAdd(&bar[XB_TMO], 1u); break; } }
    }
    nloc = mine > 0u ? mine : 1u; nx = cnt > 0u ? cnt : 1u;
}

__device__ __forceinline__ void xcd_barrier(const XcdBarrier& b) {
    asm volatile("s_waitcnt vmcnt(0)" ::: "memory");
    __syncthreads();
    if (threadIdx.x == 0) {
        unsigned* bar = b.bar;
        __builtin_amdgcn_s_waitcnt(0);
        unsigned nloc = b.st[0], nx = b.st[1];
        if (nloc == 0u) { xcd_barrier_complete(bar, b.x, nloc, nx); b.st[0] = nloc; b.st[1] = nx; }
        const unsigned old = xb_add(&bar[XB_XSUB(b.x)], 1u);
        const unsigned gen = old / nloc;
        if (old + 1u == (gen + 1u) * nloc) {
            __builtin_amdgcn_fence(__ATOMIC_RELEASE, "agent");
            asm volatile("s_waitcnt vmcnt(0)" ::: "memory");
            const unsigned og = xb_add(&bar[XB_TOP], 1u);
            const unsigned tg = og / nx;
            if (og + 1u == (tg + 1u) * nx) xb_add(&bar[XB_TOPGEN], 1u);
            else XB_SPIN(xb_ld(&bar[XB_TOPGEN]) == tg, bar);
            __builtin_amdgcn_fence(__ATOMIC_ACQUIRE, "agent");
            xb_add(&bar[XB_XGEN(b.x)], 1u);
            asm volatile("s_waitcnt vmcnt(0)" ::: "memory");
        } else {
            XB_SPIN(xb_ld(&bar[XB_XGEN(b.x)]) == gen, bar);
            __builtin_amdgcn_fence(__ATOMIC_ACQUIRE, "agent");
            asm volatile("s_waitcnt vmcnt(0)" ::: "memory");
        }
    }
    __syncthreads();
}

__global__ void __launch_bounds__(NTHREADS, 2) fwd_kernel(Args a) {
    extern __shared__ __attribute__((aligned(16))) unsigned char lds_raw[];
    LAS unsigned char* lds = (LAS unsigned char*)lds_raw;
    cg::grid_group grid = cg::this_grid();
    const int tid = threadIdx.x, lane = tid & 63, wave = __builtin_amdgcn_readfirstlane(tid >> 6);
    const int G = gridDim.x, bx = blockIdx.x;
    const int vcu = (G % 8 == 0) ? (bx % 8) * (G / 8) + bx / 8 : bx;
    unsigned char* ws = a.ws;
    float* mod = (float*)(ws + WS_MOD); float* rope = (float*)(ws + WS_ROPE);
    bf16* Win = (bf16*)(ws + WS_WIN); bf16* Wout = (bf16*)(ws + WS_WOUT); bf16* Wgu = (bf16*)(ws + WS_WGU); bf16* Wdn = (bf16*)(ws + WS_WDN);
    bf16* Kl = (bf16*)(ws + WS_KL); bf16* Vl = (bf16*)(ws + WS_VL); bf16* Kc = (bf16*)(ws + WS_KC); bf16* Vc = (bf16*)(ws + WS_VC);
    bf16* H = (bf16*)(ws + WS_H); bf16* P = (bf16*)(ws + WS_P); bf16* MRG = (bf16*)(ws + WS_MRG); bf16* ACT = (bf16*)(ws + WS_ACT); float* X1 = a.out;
    float* newk = a.out + (size_t)M_ALL * D; float* newv = newk + 16 * 256 * 128;
    const int lo = a.ph_lo, hi = a.ph_hi;
#define IN(k) (lo <= (k) && (k) < hi)
#define SEAM(k) do { if (IN(k) && IN((k) + 1)) xcd_barrier(bar); } while (0)
    volatile LAS unsigned* misc = (volatile LAS unsigned*)(lds + LDS_BYTES - 256);
    if (tid < 64) misc[tid] = 0u;
    __syncthreads();
    XcdBarrier bar = xcd_barrier_post((unsigned*)ws + a.li * XCD_BAR_WORDS, misc);
    if (a.ph_lo < 0) grid.sync();

    if (IN(0)) {
        if (bx < 96) {
            LAS float* sl = (LAS float*)lds;
            for (int i = tid; i < 9 * 1024; i += NTHREADS) { const float v = i < 8192 ? a.c[i] : a.c_ctx[i - 8192]; sl[i] = v / (1.0f + __expf(-v)); }
            __syncthreads();
            const int cgp = lane & 15, ks = lane >> 4;
            f32x4 acc[9];
#pragma unroll
            for (int r = 0; r < 9; ++r) acc[r] = (f32x4){0.f, 0.f, 0.f, 0.f};
            const float* wp = a.w_ada + (size_t)(128 * wave + ks) * MODW + 64 * bx + 4 * cgp;
#pragma unroll 1
            for (int i0 = 0; i0 < 32; i0 += 16) {
                f32x4 w[16];
#pragma unroll
                for (int j = 0; j < 16; ++j) w[j] = *(const f32x4*)(wp + (size_t)(4 * (i0 + j)) * MODW);
#pragma unroll
                for (int j = 0; j < 16; ++j) { const int k = 128 * wave + 4 * (i0 + j) + ks;
#pragma unroll
                    for (int r = 0; r < 9; ++r) acc[r] += w[j] * sl[r * 1024 + k]; }
            }
            LAS float* red = (LAS float*)(lds + 40960);
#pragma unroll
            for (int r = 0; r < 9; ++r) {
#pragma unroll
                for (int j = 0; j < 4; ++j) { float v = acc[r][j]; v += __shfl_xor(v, 16); v += __shfl_xor(v, 32); acc[r][j] = v; }
                if (ks == 0) *(LAS f32x4*)(red + (wave * 9 + r) * 64 + 4 * cgp) = acc[r];
            }
            __syncthreads();
            for (int i = tid; i < 9 * 64; i += NTHREADS) { const int r = i >> 6, l = i & 63; float s = a.b_ada[64 * bx + l];
#pragma unroll
                for (int w = 0; w < 8; ++w) s += red[(w * 9 + r) * 64 + l];
                mod[r * MODW + 64 * bx + l] = s; }
            __syncthreads();
        }
        {
            LAS float* scr = (LAS float*)(lds + wave * 17408);
            const int gw = bx * NWAVES + wave, NGW = G * NWAVES;
            constexpr int I_IN = 16 * 72, I_OUT = 16 * 32, I_GU = 16 * 176, I_DN = 44 * 32;
            const bool bal = (G == 256);
            const int nhere = bal ? I_IN + I_OUT + I_DN : I_IN + I_OUT + I_DN + I_GU;
            const int nit = bal ? (bx < 96 ? 0 : ((bx - 96) * NWAVES + wave < 512 ? 3 : 2)) : (nhere - gw + NGW - 1) / NGW;
            auto decode = [&](int ii) -> TrItem {
                const int it = bal ? (bx - 96) * NWAVES + wave + 1280 * ii : gw + ii * NGW;
                int r = it; TrItem t;
                if (r < I_IN) { const int kb = r / 72, db = r % 72, pn = db >> 3, bj = (db >> 2) & 1, wc = db & 3; const int src = pn < 3 ? 64 * (4 * pn + wc) + 32 * bj : 32 * db;
                    t = TrItem{a.w_in, IN_DIM, src, D, 64 * kb, Win, 32 * db, nullptr}; return t; } r -= I_IN;
                if (r < I_OUT) { const int kb = r / 32, db = r % 32; t = TrItem{a.w_out, D, 32 * db, D, 64 * kb, Wout, 32 * db, kb < 8 ? a.aon : a.con - 512}; return t; } r -= I_OUT;
                if (r < I_DN) { const int kb = r / 32, db = r % 32; t = TrItem{a.w_dn, D, 32 * db, D_FF, 64 * kb, Wdn, 32 * db, nullptr}; return t; } r -= I_DN;
                { const int kb = r / 176, db = r % 176, pn = db >> 3, bj = (db >> 2) & 1, qq = db & 3; const int src = (bj ? D_FF : 0) + 128 * pn + 32 * qq;
                    t = TrItem{a.w_gu, NGU, src, D, 64 * kb, Wgu, 32 * db, nullptr}; return t; }
            };
            int ii = 0;
            if (nit == 3) {
                const TrItem t0 = decode(0), t1 = decode(1), t2 = decode(2);
                float w0[32], w1[32], w2[32];
                tr_load(t0, w0, lane); tr_load(t1, w1, lane); tr_load(t2, w2, lane);
                tr_store(t0, w0, scr, lane); tr_store(t1, w1, scr + 2176, lane); tr_store(t2, w2, scr, lane);
                ii = 3;
            }
            for (; ii + 1 < nit; ii += 2) {
                const TrItem t0 = decode(ii), t1 = decode(ii + 1);
                float w0[32], w1[32];
                tr_load(t0, w0, lane); tr_load(t1, w1, lane);
                tr_store(t0, w0, scr, lane); tr_store(t1, w1, scr + 2176, lane);
            }
            if (ii < nit) { const TrItem t0 = decode(ii); float w0[32]; tr_load(t0, w0, lane); tr_store(t0, w0, scr, lane); }
        }
        {
            const int gt = bx * NTHREADS + tid, NGT = G * NTHREADS;
            for (int i = gt; i < 8 * 256 * 128; i += NGT) { const int d = i & 63, kh = (i >> 6) & 1, key = (i >> 7) & 255, b = i >> 15;
                Kl[((size_t)(b * 2 + kh) * 1280 + key) * 64 + d] = (bf16)f2bf(a.cache_k[i]);
                Vl[((size_t)(b * 2 + kh) * 64 + d) * 1280 + key] = (bf16)f2bf(a.cache_v[i]); }
            if (gt < 1024) { const int pos = gt >> 4, p = gt & 15; const float inv = 1.0f / powf(10000.0f, (float)p / 16.0f); const float ang = (float)pos * inv; rope[gt] = cosf(ang); rope[1024 + gt] = sinf(ang); }
        }
    }
    SEAM(0);
    if (IN(1)) {
        const int gw = vcu * NWAVES + wave, NGW = G * NWAVES;
        for (int m = gw; m < M_ALL; m += 2 * NGW) {
            const int m2 = m + NGW < M_ALL ? m + NGW : m;
            const float* xa = m < M_CTX ? a.xp + (size_t)m * D : a.xs + (size_t)(m - M_CTX) * D;
            const float* xb = m2 < M_CTX ? a.xp + (size_t)m2 * D : a.xs + (size_t)(m2 - M_CTX) * D;
            const float* ma = mod + (size_t)(m < M_CTX ? 8 : (m - M_CTX) >> 10) * MODW;
            const float* mb = mod + (size_t)(m2 < M_CTX ? 8 : (m2 - M_CTX) >> 10) * MODW;
            norm_rows2(xa, xb, a.norm_mix, ma + 1024, ma, mb + 1024, mb, H + (size_t)m * D, H + (size_t)m2 * D, lane);
        }
    }
    SEAM(1);
    if (IN(2)) {
        pg8::Gemm g{H, Win, M_ALL, IN_DIM, D}; pg8::StaticOrder S; S.init(M_ALL, IN_DIM, G, bx);
        pg8::EpiIn E{P, Kl, Vl, Kc, Vc, newk, newv, a.q_norm, a.k_norm, rope};
        pg8::gemm_phase<pg8::EpiIn, pg8::StaticOrder, true, true>(lds, g, S, E);
        if (G == 256 && bx >= 176) {
            LAS float* scr = (LAS float*)(lds + wave * 17408);
            constexpr int I_GU = 16 * 176;
            for (int it = (bx - 176) * NWAVES + wave; it < I_GU; it += 2 * 80 * NWAVES) {
                const int it2 = it + 80 * NWAVES;
                auto dec = [&](int r) -> TrItem { const int kb = r / 176, db = r % 176, pn = db >> 3, bj = (db >> 2) & 1, qq = db & 3; const int src = (bj ? D_FF : 0) + 128 * pn + 32 * qq; return TrItem{a.w_gu, NGU, src, D, 64 * kb, Wgu, 32 * db, nullptr}; };
                const TrItem t0 = dec(it); float w0[32]; tr_load(t0, w0, lane);
                if (it2 < I_GU) { const TrItem t1 = dec(it2); float w1[32]; tr_load(t1, w1, lane); tr_store(t0, w0, scr, lane); tr_store(t1, w1, scr + 2176, lane); }
                else tr_store(t0, w0, scr, lane);
            }
        }
    }
    SEAM(2);
    if (IN(3)) {
        for (int u = vcu; u < 384; u += G) {
            if (u < 256) { const int b = u >> 5, qb = u & 31; attn_unit(lds, P, M_CTX + b * 1024 + qb * 32, Kl + (size_t)b * 2 * 1280 * 64, Vl + (size_t)b * 2 * 64 * 1280, 1280, MRG); }
            else { const int b = (u - 256) >> 3, qb = (u - 256) & 7; attn_unit(lds, P, b * 256 + qb * 32, Kc + (size_t)b * 2 * 256 * 64, Vc + (size_t)b * 2 * 64 * 256, 256, MRG); }
        }
        const int gw = vcu * NWAVES + wave, NGW = G * NWAVES;
        if (G == 256) { if (vcu >= 128) { const int w2 = (vcu - 128) * NWAVES + wave; conv_run6(P, a.conv_w, 6 * w2, MRG, lane); conv_run6(P, a.conv_w, 6 * (w2 + 1024), MRG, lane); } }
        else for (int r = gw; r < M_ALL / 6; r += NGW) conv_run6(P, a.conv_w, 6 * r, MRG, lane);
    }
    SEAM(3);
    if (IN(4)) {
        pg8::Gemm g{MRG, Wout, M_ALL, D, D}; pg8::StaticOrder S; S.init(M_ALL, D, G, bx, 192);
        pg8::EpiRes3 E{a.xp, a.xs, X1, mod + 2048};
        pg8::gemm_phase<pg8::EpiRes3, pg8::StaticOrder, true, true>(lds, g, S, E);
    }
    SEAM(4);
    if (IN(5)) {
        const int gw = vcu * NWAVES + wave, NGW = G * NWAVES;
        for (int m = gw; m < M_ALL; m += 2 * NGW) {
            const int m2 = m + NGW < M_ALL ? m + NGW : m;
            const float* ma = mod + (size_t)(m < M_CTX ? 8 : (m - M_CTX) >> 10) * MODW;
            const float* mb = mod + (size_t)(m2 < M_CTX ? 8 : (m2 - M_CTX) >> 10) * MODW;
            norm_rows2(X1 + (size_t)m * D, X1 + (size_t)m2 * D, a.norm_ffn, ma + 4096, ma + 3072, mb + 4096, mb + 3072, H + (size_t)m * D, H + (size_t)m2 * D, lane);
        }
    }
    SEAM(5);
    if (IN(6)) {
        constexpr int M_BIG = 18 * 256;
        { pg8::Gemm g{H, Wgu, M_BIG, NGU, D}; pg8::StaticOrder S; S.init(M_BIG, NGU, G, bx);
          pg8::EpiSwiGLU E{ACT, D_FF};
          pg8::gemm_phase<pg8::EpiSwiGLU, pg8::StaticOrder, true, true>(lds, g, S, E); }
        { pg8::Gemm g{H + (size_t)M_BIG * D, Wgu, M_ALL - M_BIG, NGU, D}; pg8::StaticOrder S; S.init(M_ALL - M_BIG, NGU, G, (bx + 116) % G, 192);
          pg8::EpiSwiGLU3 E{ACT, D_FF, M_BIG};
          pg8::gemm_phase<pg8::EpiSwiGLU3, pg8::StaticOrder, true, true>(lds, g, S, E); }
    }
    SEAM(6);
    if (IN(7)) {
        pg8::Gemm g{ACT, Wdn, M_ALL, D, D_FF}; pg8::StaticOrder S; S.init(M_ALL, D, G, bx, 192);
        pg8::EpiRes3 E{X1, X1 + (size_t)M_CTX * D, a.out, mod + 5120};
        pg8::gemm_phase<pg8::EpiRes3, pg8::StaticOrder, true, true>(lds, g, S, E);
    }
#undef IN
#undef SEAM
}

#ifndef MK_N_LAUNCHES
#define MK_N_LAUNCHES 1
#endif
extern "C" void kernel_launch(void* const* d_in, const int* in_sizes, int n_in, void* d_out, int out_size, void* d_ws, size_t ws_size, hipStream_t stream) {
    static int grid = 0;
    if (grid == 0) {
        int dev = 0, cus = 0, per_cu = 0;
        hipGetDevice(&dev); hipDeviceGetAttribute(&cus, hipDeviceAttributeMultiprocessorCount, dev);
        if (hipFuncSetAttribute((const void*)fwd_kernel, hipFuncAttributeMaxDynamicSharedMemorySize, LDS_BYTES) != hipSuccess) { fprintf(stderr, "kernel_launch: hipFuncSetAttribute failed\n"); grid = -1; return; }
        hipOccupancyMaxActiveBlocksPerMultiprocessor(&per_cu, (const void*)fwd_kernel, NTHREADS, LDS_BYTES);
        (void)hipGetLastError();
        if (per_cu < 1) { fprintf(stderr, "kernel_launch: occupancy query says %d blocks per CU\n", per_cu); per_cu = 1; }
        grid = cus;
        if (n_in != 19 || ws_size < WS_END) { fprintf(stderr, "kernel_launch: unexpected n_in %d / ws %zu\n", n_in, ws_size); grid = -1; return; }
    }
    if (grid < 0) return;
    Args a{};
    a.xp = (const float*)d_in[0]; a.xs = (const float*)d_in[1]; a.c = (const float*)d_in[2]; a.cache_k = (const float*)d_in[3]; a.cache_v = (const float*)d_in[4]; a.c_ctx = (const float*)d_in[5];
    a.norm_mix = (const float*)d_in[6]; a.norm_ffn = (const float*)d_in[7]; a.w_ada = (const float*)d_in[8]; a.b_ada = (const float*)d_in[9]; a.w_in = (const float*)d_in[10];
    a.q_norm = (const float*)d_in[11]; a.k_norm = (const float*)d_in[12]; a.conv_w = (const float*)d_in[13]; a.aon = (const float*)d_in[14]; a.con = (const float*)d_in[15];
    a.w_out = (const float*)d_in[16]; a.w_gu = (const float*)d_in[17]; a.w_dn = (const float*)d_in[18]; a.out = (float*)d_out; a.ws = (unsigned char*)d_ws;
#if MK_N_LAUNCHES == 1
    (void)hipMemsetAsync(d_ws, 0, 65536, stream);
    void* args[] = {&a};
    if (PROBE_DUP >= 0) {
        a.ph_lo = 0; a.ph_hi = PROBE_DUP > 7 ? 0 : PROBE_DUP + 1;
        (void)hipLaunchCooperativeKernel((const void*)fwd_kernel, dim3(grid), dim3(NTHREADS), args, LDS_BYTES, stream);
        a.ph_lo = PROBE_DUP > 7 ? 0 : PROBE_DUP; a.ph_hi = 8; a.li = 1;
    } else { a.ph_lo = 0; a.ph_hi = 8; }
    hipError_t e = hipLaunchCooperativeKernel((const void*)fwd_kernel, dim3(grid), dim3(NTHREADS), args, LDS_BYTES, stream);
    if (e != hipSuccess) fprintf(stderr, "cooperative launch failed: %s (grid %d)\n", hipGetErrorString(e), grid);
#else
    for (int p = 0; p < 8; ++p) { a.ph_lo = p; a.ph_hi = p + 1; hipLaunchKernelGGL(fwd_kernel, dim3(grid), dim3(NTHREADS), LDS_BYTES, stream, a); }
#endif
}
```

```cpp
#include <hip/hip_runtime.h>
#include <hip/hip_cooperative_groups.h>
#include <cstdio>
#include <cstdint>
namespace cg = cooperative_groups;
#ifndef PROBE_DUP
#define PROBE_DUP -1
#endif
namespace pg8 {
#define PG8_LAS __attribute__((address_space(3)))
typedef unsigned short bf16_t;
typedef short bf16x8 __attribute__((ext_vector_type(8)));
typedef float f32x4 __attribute__((ext_vector_type(4)));
typedef unsigned u32x4 __attribute__((ext_vector_type(4)));
constexpr int BM = 256, BK = 64, HALF = 128, HTB = HALF * BK * 2  , STAGE_BYTES = 8 * HTB, NXCD = 8, WGM = 8;

__host__ __device__ __forceinline__ int lds_byte(int r, int c) { const int st = (r >> 4) * 2 + (c >> 5), rr = r & 15, cc = c & 31, ob = rr * 64 + cc * 2; return st * 1024 + (ob ^ (((ob >> 9) & 1) << 5)); }
__host__ __device__ __forceinline__ void stage_rc(int b, int& R, int& C) { const int st = b / 1024, sb = b % 1024, swz = sb ^ (((sb >> 9) & 1) << 5); R = (st >> 1) * 16 + swz / 64; C = (st & 1) * 32 + (swz % 64) / 2; }
__host__ __device__ __forceinline__ int perm32(int rho) { const int n = rho >> 4, i = rho & 15; return 8 * (i >> 2) + 4 * n + (i & 3); }

struct Unit { int pm, pn; };
struct Gemm { const bf16_t* A; const bf16_t* Bt; int M, N, K; };

struct StaticOrder {
    int nM, nN, nwg, G, c;
    __host__ __device__ void init(int M, int N, int G_, int c_, int bm = BM) { nM = M / bm; nN = N / BM; nwg = nM * nN; G = G_; c = c_; }
    __host__ __device__ bool next(int i, Unit& u) const {
        const long L = (long)i * G + c; if (L >= nwg) return false;
        int wgid = (int)L; { const int q = nwg / NXCD, r = nwg % NXCD, xcd = wgid % NXCD, off = wgid / NXCD; wgid = (xcd < r ? xcd * (q + 1) : r * (q + 1) + (xcd - r) * q) + off; }
        const int nig = WGM * nN, gid = wgid / nig, fm = gid * WGM, gsz = (nM - fm) < WGM ? (nM - fm) : WGM;
        u.pm = fm + ((wgid % nig) % gsz); u.pn = (wgid % nig) / gsz; return true;
    }
    __device__ __forceinline__ void a_ready(const Unit&) const {}
    __device__ __forceinline__ void done(const Unit&) const {}
};
typedef float f32x2cv_t __attribute__((ext_vector_type(2))); typedef __bf16 bf16x2cv_t __attribute__((ext_vector_type(2)));
__device__ __forceinline__ unsigned cvt_pk_bf16(float lo, float hi) { f32x2cv_t v = {lo, hi}; bf16x2cv_t b = __builtin_convertvector(v, bf16x2cv_t); return __builtin_bit_cast(unsigned, b); }
typedef float f32x2 __attribute__((ext_vector_type(2)));
template <class Epi, class Sched, bool ALIGN_EPI = false, bool SP2 = false>
__device__ __forceinline__ void gemm_phase(PG8_LAS unsigned char* lds, const Gemm g, const Sched& S, const Epi& E) {
    const int tid = threadIdx.x, wid = __builtin_amdgcn_readfirstlane(tid >> 6), lane = tid & 63, wr = wid >> 2, wc = wid & 3, fr = lane & 15, fq = lane >> 4;
    const int K = g.K, nt = K / BK;
    unsigned voffA[2], voffB[2];
#pragma unroll
    for (int i = 0; i < 2; ++i) { int R, C; stage_rc(tid * 16 + i * 8192, R, C); const int Rb = Epi::PERM ? ((R & ~31) + perm32(R & 31)) : R;
        voffA[i] = (unsigned)(R * K + C) * 2u; voffB[i] = (unsigned)(Rb * K + C) * 2u; }
    const size_t kstep = (size_t)(BK * 2);
    constexpr int MT = Epi::MT, HA = 32 * MT;
    const size_t hstepA = (size_t)HA * K * 2, hstep = (size_t)HALF * K * 2;
    const size_t tstepA = 2 * hstepA, tstep = 2 * hstep;
    const unsigned ldsw = (unsigned)wid * 1024u;
    const int aoff = lds_byte(wr * (16 * MT) + fr, fq * 8), boff = lds_byte(wc * 32 + fr, fq * 8);
#define PG8_SA(b, h) (((b) * 2 + (h)) * HTB)
#define PG8_SB(b, h) ((4 + (b) * 2 + (h)) * HTB)
#define PG8_STAGE(bufoff, gbase, voff) do { _Pragma("unroll") for (int _i = 0; _i < 2; ++_i) \
        __builtin_amdgcn_global_load_lds((const unsigned*)((const char*)(gbase) + (voff)[_i]), (PG8_LAS unsigned*)(lds + (bufoff) + ldsw + _i * 8192), 16, 0, 0); } while (0)
#define PG8_LDA(dst, b, h) do { _Pragma("unroll") for (int m = 0; m < MT; ++m) _Pragma("unroll") for (int k = 0; k < 2; ++k) dst[m][k] = *(const PG8_LAS bf16x8*)(lds + PG8_SA(b, h) + aoff + m * 2048 + k * 1024); } while (0)
#define PG8_LDB(dst, b, h) do { _Pragma("unroll") for (int n = 0; n < 2; ++n) _Pragma("unroll") for (int k = 0; k < 2; ++k) dst[n][k] = *(const PG8_LAS bf16x8*)(lds + PG8_SB(b, h) + boff + n * 2048 + k * 1024); } while (0)
#define PG8_MMA(ai, bj, At, Bt) do { __builtin_amdgcn_s_setprio(1); _Pragma("unroll") for (int m = 0; m < MT; ++m) _Pragma("unroll") for (int n = 0; n < 2; ++n) _Pragma("unroll") for (int k = 0; k < 2; ++k) \
        acc[ai][bj][m][n] = __builtin_amdgcn_mfma_f32_16x16x32_bf16(Bt[n][k], At[m][k], acc[ai][bj][m][n], 0, 0, 0); __builtin_amdgcn_s_setprio(0); } while (0)
#define PG8_WAIT_V(n) asm volatile("s_waitcnt vmcnt(" #n ")" ::: "memory")
#define PG8_WAIT_L(n) asm volatile("s_waitcnt lgkmcnt(" #n ")" ::: "memory")
#define PG8_BAR __builtin_amdgcn_s_barrier()
#define PG8_SCHED __builtin_amdgcn_sched_barrier(0)
    Unit cur, nxt; int ui = 0;
    if (!S.next(0, cur)) return;
    f32x4 acc[2][2][MT][2];
#pragma unroll
    for (int a = 0; a < 2; ++a)
#pragma unroll
        for (int b = 0; b < 2; ++b)
#pragma unroll
            for (int m = 0; m < MT; ++m)
#pragma unroll
                for (int n = 0; n < 2; ++n) acc[a][b][m][n] = (f32x4){0.f, 0.f, 0.f, 0.f};
    bf16x8 At[MT][2], B0[2][2], B1[2][2];
    const char* cA = (const char*)g.A + (size_t)cur.pm * tstepA; const char* cB = (const char*)g.Bt + (size_t)cur.pn * tstep;
    S.a_ready(cur);
    if constexpr (SP2) {
        PG8_STAGE(PG8_SB(0, 0), cB, voffB); PG8_STAGE(PG8_SB(0, 1), cB + hstep, voffB); PG8_STAGE(PG8_SA(0, 0), cA, voffA); PG8_STAGE(PG8_SA(0, 1), cA + hstepA, voffA);
        if (wr == 1) PG8_BAR;
        PG8_WAIT_V(2); PG8_BAR;
        PG8_STAGE(PG8_SB(1, 0), cB + kstep, voffB); PG8_STAGE(PG8_SA(1, 0), cA + kstep, voffA); PG8_STAGE(PG8_SB(1, 1), cB + hstep + kstep, voffB);
        PG8_WAIT_V(6); PG8_BAR;
    } else {
        PG8_STAGE(PG8_SB(0, 0), cB, voffB); PG8_STAGE(PG8_SA(0, 0), cA, voffA); PG8_STAGE(PG8_SB(0, 1), cB + hstep, voffB); PG8_STAGE(PG8_SA(0, 1), cA + hstepA, voffA);
        if (wr == 1) PG8_BAR;
        PG8_WAIT_V(4); PG8_BAR;
        PG8_STAGE(PG8_SB(1, 0), cB + kstep, voffB); PG8_STAGE(PG8_SA(1, 0), cA + kstep, voffA); PG8_STAGE(PG8_SB(1, 1), cB + hstep + kstep, voffB);
        PG8_WAIT_V(6); PG8_BAR;
    }
    for (;;) {
        const bool has_next = S.next(ui + 1, nxt);
        const char* nA = has_next ? (const char*)g.A + (size_t)nxt.pm * tstepA : cA; const char* nB = has_next ? (const char*)g.Bt + (size_t)nxt.pn * tstep : cB;
        for (int t = 0; t < nt; t += 2) {
            const bool last = (t == nt - 2);
            const char* a1 = cA + (size_t)(t + 1) * kstep;
            const char* a2 = last ? nA : cA + (size_t)(t + 2) * kstep; const char* b2 = last ? nB : cB + (size_t)(t + 2) * kstep;
            const char* a3 = a2 + kstep; const char* b3 = b2 + kstep;
            if (last && has_next) S.a_ready(nxt);
            if constexpr (SP2) {
            PG8_LDB(B0, 0, 0); PG8_LDB(B1, 0, 1); PG8_SCHED; PG8_LDA(At, 0, 0); PG8_STAGE(PG8_SA(1, 1), a1 + hstepA, voffA);
            PG8_WAIT_V(8); PG8_WAIT_L(0); PG8_BAR; PG8_MMA(0, 0, At, B0); PG8_MMA(0, 1, At, B1); PG8_BAR; PG8_SCHED;
            PG8_LDA(At, 0, 1); PG8_STAGE(PG8_SB(0, 0), b2, voffB); PG8_STAGE(PG8_SB(0, 1), b2 + hstep, voffB); PG8_STAGE(PG8_SA(0, 0), a2, voffA);
            PG8_WAIT_V(8); PG8_WAIT_L(0); PG8_BAR; PG8_MMA(1, 0, At, B0); PG8_MMA(1, 1, At, B1); PG8_BAR; PG8_SCHED;
            PG8_LDB(B0, 1, 0); PG8_LDB(B1, 1, 1); PG8_SCHED; PG8_LDA(At, 1, 0); PG8_STAGE(PG8_SA(0, 1), a2 + hstepA, voffA);
            PG8_WAIT_V(8); PG8_WAIT_L(0); PG8_BAR; PG8_MMA(0, 0, At, B0); PG8_MMA(0, 1, At, B1); PG8_BAR; PG8_SCHED;
            PG8_LDA(At, 1, 1); PG8_STAGE(PG8_SB(1, 0), b3, voffB); PG8_STAGE(PG8_SB(1, 1), b3 + hstep, voffB); PG8_STAGE(PG8_SA(1, 0), a3, voffA);
            PG8_WAIT_V(8); PG8_WAIT_L(0); PG8_BAR; PG8_MMA(1, 0, At, B0); PG8_MMA(1, 1, At, B1); PG8_BAR; PG8_SCHED;
            } else {
            PG8_LDB(B0, 0, 0); PG8_SCHED; PG8_LDA(At, 0, 0); PG8_STAGE(PG8_SA(1, 1), a1 + hstepA, voffA);
            PG8_WAIT_L(8); PG8_BAR; PG8_WAIT_L(0); PG8_MMA(0, 0, At, B0); PG8_BAR; PG8_SCHED;
            PG8_LDB(B1, 0, 1); PG8_STAGE(PG8_SB(0, 0), b2, voffB);
            PG8_BAR; PG8_WAIT_L(0); PG8_MMA(0, 1, At, B1); PG8_BAR;
            PG8_LDA(At, 0, 1); PG8_STAGE(PG8_SA(0, 0), a2, voffA);
            PG8_BAR; PG8_WAIT_L(0); PG8_MMA(1, 0, At, B0); PG8_BAR; PG8_SCHED;
            PG8_STAGE(PG8_SB(0, 1), b2 + hstep, voffB);
            PG8_WAIT_V(6); PG8_BAR; PG8_MMA(1, 1, At, B1); PG8_BAR;
            PG8_LDB(B0, 1, 0); PG8_SCHED; PG8_LDA(At, 1, 0); PG8_STAGE(PG8_SA(0, 1), a2 + hstepA, voffA);
            PG8_WAIT_L(8); PG8_BAR; PG8_WAIT_L(0); PG8_MMA(0, 0, At, B0); PG8_BAR; PG8_SCHED;
            PG8_LDB(B1, 1, 1); PG8_STAGE(PG8_SB(1, 0), b3, voffB);
            PG8_BAR; PG8_WAIT_L(0); PG8_MMA(0, 1, At, B1); PG8_BAR;
            PG8_LDA(At, 1, 1); PG8_STAGE(PG8_SA(1, 0), a3, voffA);
            PG8_BAR; PG8_WAIT_L(0); PG8_MMA(1, 0, At, B0); PG8_BAR; PG8_SCHED;
            PG8_STAGE(PG8_SB(1, 1), b3 + hstep, voffB);
            PG8_WAIT_V(6); PG8_BAR; PG8_MMA(1, 1, At, B1); PG8_BAR;
            }
        }
        if constexpr (ALIGN_EPI) { if (wr == 0) PG8_BAR; }
        if constexpr (!Epi::AFTER_DRAIN) { E(acc, cur, wr, wc, fr, fq); S.done(cur); }
        if (!has_next) break;
#pragma unroll
        for (int a = 0; a < 2; ++a)
#pragma unroll
            for (int b = 0; b < 2; ++b)
#pragma unroll
                for (int m = 0; m < MT; ++m)
#pragma unroll
                    for (int n = 0; n < 2; ++n) acc[a][b][m][n] = (f32x4){0.f, 0.f, 0.f, 0.f};
        cur = nxt; cA = nA; cB = nB; ++ui;
        if constexpr (ALIGN_EPI) { if (wr == 1) PG8_BAR; }
    }
    PG8_WAIT_V(0);
    if constexpr (!ALIGN_EPI) { if (wr == 0) PG8_BAR; }
    PG8_BAR;
    if constexpr (Epi::AFTER_DRAIN) { E.fused(acc, cur, wr, wc, fr, fq, lds, wid, lane); S.done(cur); }
#undef PG8_SA
#undef PG8_SB
#undef PG8_STAGE
#undef PG8_LDA
#undef PG8_LDB
#undef PG8_MMA
#undef PG8_WAIT_V
#undef PG8_WAIT_L
#undef PG8_BAR
#undef PG8_SCHED
}
constexpr int TOK_CTX = 4096, TOK_ALL = 12288, PITCH_P = 2304;
constexpr float RMS_EPS_F = 1e-6f;
constexpr float QSCALE = 0.125f * 1.4426950408889634f;
__device__ __forceinline__ u32x4 pack8(const f32x4 a, const f32x4 b) { u32x4 w; w.x = cvt_pk_bf16(a[0], a[1]); w.y = cvt_pk_bf16(a[2], a[3]); w.z = cvt_pk_bf16(b[0], b[1]); w.w = cvt_pk_bf16(b[2], b[3]); return w; }
__device__ __forceinline__ unsigned short bf1(float f) { return (unsigned short)(cvt_pk_bf16(f, 0.f) & 0xffffu); }

struct EpiIn {
    static constexpr bool PERM = true, AFTER_DRAIN = false; static constexpr int MT = 4;
    bf16_t* P; bf16_t* Kl; bf16_t* Vl; bf16_t* Kc; bf16_t* Vc; float* newk; float* newv; const float* qn; const float* kn; const float* rope;
    __device__ __forceinline__ void operator()(const f32x4 (&acc)[2][2][4][2], const Unit& u, int wr, int wc, int fr, int fq) const {
        const int row0 = u.pm * BM + wr * 64 + fr;
        if (u.pn >= 3) {
            const int col0 = u.pn * BM + wc * 32 + 8 * fq;
#pragma unroll
            for (int ai = 0; ai < 2; ++ai)
#pragma unroll
                for (int m = 0; m < 4; ++m) { bf16_t* rowp = P + (size_t)(row0 + ai * HALF + m * 16) * PITCH_P + col0;
#pragma unroll
                    for (int bj = 0; bj < 2; ++bj) *(u32x4*)(rowp + bj * HALF) = pack8(acc[ai][bj][m][0], acc[ai][bj][m][1]); }
            return;
        }
        const int head = 4 * u.pn + wc;
        const bool lat = u.pm >= 16;
        if (head < 10) {
            const float* gsrc = head < 8 ? qn : kn;
            const float oscale = head < 8 ? QSCALE : 1.0f;
            f32x4 g[2][2];
#pragma unroll
            for (int bj = 0; bj < 2; ++bj)
#pragma unroll
                for (int n = 0; n < 2; ++n) g[bj][n] = *(const f32x4*)(gsrc + 32 * bj + 8 * fq + 4 * n);
            const float sgn = (fq & 2) ? 1.0f : -1.0f;
#pragma unroll
            for (int ai = 0; ai < 2; ++ai)
#pragma unroll
                for (int m = 0; m < 4; ++m) {
                    const int r = row0 + ai * HALF + m * 16;
                    float ss = 0.f;
#pragma unroll
                    for (int bj = 0; bj < 2; ++bj)
#pragma unroll
                        for (int n = 0; n < 2; ++n) { const f32x4 x = acc[ai][bj][m][n]; ss += (x[0] * x[0] + x[1] * x[1]) + (x[2] * x[2] + x[3] * x[3]); }
                    ss += __shfl_xor(ss, 16); ss += __shfl_xor(ss, 32);
                    const float rinv = 1.0f / sqrtf(ss * (1.0f / 64.0f) + RMS_EPS_F);
                    f32x4 v[2][2];
#pragma unroll
                    for (int bj = 0; bj < 2; ++bj)
#pragma unroll
                        for (int n = 0; n < 2; ++n) v[bj][n] = acc[ai][bj][m][n] * rinv * g[bj][n];
                    if (!lat && head >= 8) {
                        float* nk = newk + ((size_t)r * 2 + (head - 8)) * 64 + 8 * fq;
#pragma unroll
                        for (int bj = 0; bj < 2; ++bj)
#pragma unroll
                            for (int n = 0; n < 2; ++n) *(f32x4*)(nk + 32 * bj + 4 * n) = v[bj][n];
                    }
                    if (lat) {
                        const int s = (r - TOK_CTX) & 1023;
#pragma unroll
                        for (int bj = 0; bj < 2; ++bj) {
                            const int pos = bj == 0 ? (s >> 6) : (s & 63);
#pragma unroll
                            for (int n = 0; n < 2; ++n) {
                                const f32x4 cs = *(const f32x4*)(rope + pos * 16 + 8 * (fq & 1) + 4 * n);
                                const f32x4 sn = *(const f32x4*)(rope + 1024 + pos * 16 + 8 * (fq & 1) + 4 * n);
                                f32x4 pt;
#pragma unroll
                                for (int j = 0; j < 4; ++j) pt[j] = __shfl_xor(v[bj][n][j], 32);
                                v[bj][n] = v[bj][n] * cs + pt * (sn * sgn);
                            }
                        }
                    }
                    bf16_t* dst;
                    if (head < 8) dst = P + (size_t)r * PITCH_P + head * 64 + 8 * fq;
                    else if (lat) { const int b = (r - TOK_CTX) >> 10, s = (r - TOK_CTX) & 1023; dst = Kl + ((size_t)(b * 2 + (head - 8)) * 1280 + 256 + s) * 64 + 8 * fq; }
                    else { const int b = r >> 8, s = r & 255; dst = Kc + ((size_t)(b * 2 + (head - 8)) * 256 + s) * 64 + 8 * fq; }
#pragma unroll
                    for (int bj = 0; bj < 2; ++bj) *(u32x4*)(dst + 32 * bj) = pack8(v[bj][0] * oscale, v[bj][1] * oscale);
                }
        } else {
            const int kvh = head - 10;
#pragma unroll
            for (int ai = 0; ai < 2; ++ai)
#pragma unroll
                for (int m = 0; m < 4; ++m) {
                    const int r = row0 + ai * HALF + m * 16;
                    bf16_t* vt; int T;
                    if (lat) { const int b = (r - TOK_CTX) >> 10, s = (r - TOK_CTX) & 1023; T = 1280; vt = Vl + (size_t)(b * 2 + kvh) * 64 * 1280 + 256 + s; }
                    else { const int b = r >> 8, s = r & 255; T = 256; vt = Vc + (size_t)(b * 2 + kvh) * 64 * 256 + s;
                        float* nv = newv + ((size_t)r * 2 + kvh) * 64 + 8 * fq;
#pragma unroll
                        for (int bj = 0; bj < 2; ++bj)
#pragma unroll
                            for (int n = 0; n < 2; ++n) *(f32x4*)(nv + 32 * bj + 4 * n) = acc[ai][bj][m][n]; }
#pragma unroll
                    for (int bj = 0; bj < 2; ++bj)
#pragma unroll
                        for (int n = 0; n < 2; ++n)
#pragma unroll
                            for (int j = 0; j < 4; ++j) vt[(size_t)(32 * bj + 8 * fq + 4 * n + j) * T] = bf1(acc[ai][bj][m][n][j]);
                }
        }
    }
};

struct EpiRes {
    static constexpr bool PERM = false, AFTER_DRAIN = false; static constexpr int MT = 4;
    const float* xa; const float* xb; float* out; const float* gate;
    __device__ __forceinline__ void operator()(const f32x4 (&acc)[2][2][4][2], const Unit& u, int wr, int wc, int fr, int fq) const {
        const int row0 = u.pm * BM + wr * 64 + fr, col0 = u.pn * BM + wc * 32 + 4 * fq;
        const int mrow = u.pm < 16 ? 8 : ((u.pm - 16) >> 2);
        f32x4 g[2][2];
#pragma unroll
        for (int bj = 0; bj < 2; ++bj)
#pragma unroll
            for (int n = 0; n < 2; ++n) g[bj][n] = *(const f32x4*)(gate + (size_t)mrow * 6144 + col0 + bj * HALF + n * 16);
#pragma unroll
        for (int ai = 0; ai < 2; ++ai)
#pragma unroll
            for (int m = 0; m < 4; ++m) {
                const int r = row0 + ai * HALF + m * 16;
                const float* bp = (r < TOK_CTX ? xa + (size_t)r * 1024 : xb + (size_t)(r - TOK_CTX) * 1024) + col0;
                float* op = out + (size_t)r * 1024 + col0;
#pragma unroll
                for (int bj = 0; bj < 2; ++bj)
#pragma unroll
                    for (int n = 0; n < 2; ++n) { const f32x4 b = *(const f32x4*)(bp + bj * HALF + n * 16); *(f32x4*)(op + bj * HALF + n * 16) = b + g[bj][n] * acc[ai][bj][m][n]; }
            }
    }
};

struct EpiSwiGLU {
    static constexpr bool PERM = true, AFTER_DRAIN = false; static constexpr int MT = 4;
    bf16_t* act; int ldc;
    __device__ __forceinline__ void operator()(const f32x4 (&acc)[2][2][4][2], const Unit& u, int wr, int wc, int fr, int fq) const {
        const int row0 = u.pm * BM + wr * 64 + fr, col0 = u.pn * HALF + wc * 32 + 8 * fq;
#pragma unroll
        for (int ai = 0; ai < 2; ++ai)
#pragma unroll
            for (int m = 0; m < 4; ++m) {
                f32x4 o[2];
#pragma unroll
                for (int n = 0; n < 2; ++n) {
                    const f32x4 gt = acc[ai][0][m][n], up = acc[ai][1][m][n];
#pragma unroll
                    for (int j = 0; j < 4; ++j) { const float e = __builtin_amdgcn_exp2f(gt[j] * -1.4426950408889634f); o[n][j] = gt[j] * __builtin_amdgcn_rcpf(1.0f + e) * up[j]; }
                }
                *(u32x4*)(act + (size_t)(row0 + ai * HALF + m * 16) * ldc + col0) = pack8(o[0], o[1]);
            }
    }
};

struct EpiRes3 {
    static constexpr bool PERM = false, AFTER_DRAIN = false; static constexpr int MT = 3;
    const float* xa; const float* xb; float* out; const float* gate; bool nt_out;
    __device__ __forceinline__ void operator()(const f32x4 (&acc)[2][2][3][2], const Unit& u, int wr, int wc, int fr, int fq) const {
        const int col0 = u.pn * BM + wc * 32 + 4 * fq;
#pragma unroll
        for (int ai = 0; ai < 2; ++ai)
#pragma unroll
            for (int m = 0; m < 3; ++m) {
                const int rg = u.pm * 192 + ai * 96 + wr * 48 + m * 16, r = rg + fr;
                const int mrow = rg < TOK_CTX ? 8 : ((rg - TOK_CTX) >> 10);
                const float* gp = gate + (size_t)mrow * 6144 + col0;
                const float* bp = (r < TOK_CTX ? xa + (size_t)r * 1024 : xb + (size_t)(r - TOK_CTX) * 1024) + col0;
                float* op = out + (size_t)r * 1024 + col0;
#pragma unroll
                for (int bj = 0; bj < 2; ++bj)
#pragma unroll
                    for (int n = 0; n < 2; ++n) { const f32x4 b = *(const f32x4*)(bp + bj * HALF + n * 16), g = *(const f32x4*)(gp + bj * HALF + n * 16); const f32x4 y = b + g * acc[ai][bj][m][n];
                        if (nt_out) __builtin_nontemporal_store(y, (f32x4*)(op + bj * HALF + n * 16)); else *(f32x4*)(op + bj * HALF + n * 16) = y; }
            }
    }
};
struct EpiSwiGLU3 {
    static constexpr bool PERM = true, AFTER_DRAIN = false; static constexpr int MT = 3;
    bf16_t* act; int ldc;
    __device__ __forceinline__ void operator()(const f32x4 (&acc)[2][2][3][2], const Unit& u, int wr, int wc, int fr, int fq) const {
        const int col0 = u.pn * HALF + wc * 32 + 8 * fq;
#pragma unroll
        for (int ai = 0; ai < 2; ++ai)
#pragma unroll
            for (int m = 0; m < 3; ++m) {
                const int r = u.pm * 192 + ai * 96 + wr * 48 + m * 16 + fr;
                f32x4 o[2];
#pragma unroll
                for (int n = 0; n < 2; ++n) {
                    const f32x4 gt = acc[ai][0][m][n], up = acc[ai][1][m][n];
#pragma unroll
                    for (int j = 0; j < 4; ++j) { const float e = __builtin_amdgcn_exp2f(gt[j] * -1.4426950408889634f); o[n][j] = gt[j] * __builtin_amdgcn_rcpf(1.0f + e) * up[j]; }
                }
                *(u32x4*)(act + (size_t)r * ldc + col0) = pack8(o[0], o[1]);
            }
    }
};
}
#define GAS __attribute__((address_space(1)))
#define LAS __attribute__((address_space(3)))
typedef unsigned short bf16;
typedef unsigned v4u __attribute__((ext_vector_type(4)));
typedef float f32x4 __attribute__((ext_vector_type(4)));
typedef float f32x16 __attribute__((ext_vector_type(16)));
typedef short bf16x8 __attribute__((ext_vector_type(8)));
constexpr int NWAVES = 8, NTHREADS = 512;
constexpr int D = 1024, M_CTX = 4096, M_ALL = 12288, IN_DIM = 2304, D_FF = 2816, NGU = 5632, MODW = 6144;
constexpr size_t MiB = 1u << 20;
constexpr size_t WS_MOD = 1 * MiB, WS_ROPE = 1 * MiB + 512 * 1024, WS_WIN = 2 * MiB, WS_WOUT = 7 * MiB, WS_WGU = 9 * MiB, WS_WDN = 20 * MiB;
constexpr size_t WS_KL = 26 * MiB, WS_VL = 29 * MiB, WS_KC = 32 * MiB, WS_VC = 33 * MiB, WS_H = 34 * MiB, WS_P = 58 * MiB, WS_MRG = 34 * MiB  , WS_ACT = 58 * MiB  , WS_END = 124 * MiB;
constexpr int RING_BYTES = 131072, LDS_BYTES = 147456;

__device__ __forceinline__ unsigned f2bf(float f) { unsigned u = __builtin_bit_cast(unsigned, f); return (u + 0x7fffu + ((u >> 16) & 1u)) >> 16; }
__device__ __forceinline__ unsigned pk2(float lo, float hi) { return f2bf(lo) | (f2bf(hi) << 16); }
__device__ __forceinline__ float bf2f(unsigned short h) { return __builtin_bit_cast(float, (unsigned)h << 16); }
__device__ __forceinline__ float wave_sum(float v) {
#pragma unroll
    for (int o = 1; o < 64; o <<= 1) v += __shfl_xor(v, o);
    return v;
}
#define LDS_WAIT() asm volatile("s_waitcnt lgkmcnt(0)" ::: "memory")

struct Args {
    const float* xp; const float* xs; const float* c; const float* cache_k; const float* cache_v; const float* c_ctx; const float* norm_mix; const float* norm_ffn;
    const float* w_ada; const float* b_ada; const float* w_in; const float* q_norm; const float* k_norm; const float* conv_w; const float* aon; const float* con;
    const float* w_out; const float* w_gu; const float* w_dn; float* out; unsigned char* ws; int ph_lo, ph_hi, li, pad;
};

__device__ __forceinline__ void transpose_item(const float* W, int ldw, int src0, int K, int k0, bf16* WT, int dst0, const float* kgain, LAS float* scr, int lane) {
#pragma unroll
    for (int i = 0; i < 32; ++i) { const int kk = 2 * i + (lane >> 5); float w = W[(size_t)(k0 + kk) * ldw + src0 + (lane & 31)]; if (kgain) w *= kgain[k0 + kk]; scr[kk * 33 + (lane & 31)] = w; }
    LDS_WAIT(); asm volatile("" ::: "memory");
    const int c = lane & 7;
#pragma unroll
    for (int j = 0; j < 4; ++j) { const int n = (lane >> 3) + 8 * j; const LAS float* s = scr + (8 * c) * 33 + n;
        v4u o; o.x = pk2(s[0 * 33], s[1 * 33]); o.y = pk2(s[2 * 33], s[3 * 33]); o.z = pk2(s[4 * 33], s[5 * 33]); o.w = pk2(s[6 * 33], s[7 * 33]);
        *(v4u*)(WT + (size_t)(dst0 + n) * K + k0 + 8 * c) = o; }
    LDS_WAIT(); asm volatile("" ::: "memory");
}

struct TrItem { const float* W; int ldw, src0, K, k0; bf16* WT; int dst0; const float* gain; };
__device__ __forceinline__ void tr_load(const TrItem& t, float (&w)[32], int lane) {
#pragma unroll
    for (int i = 0; i < 32; ++i) { const int kk = 2 * i + (lane >> 5); w[i] = __builtin_nontemporal_load(&t.W[(size_t)(t.k0 + kk) * t.ldw + t.src0 + (lane & 31)]); }
}
__device__ __forceinline__ void tr_store(const TrItem& t, const float (&w)[32], LAS float* scr, int lane) {
#pragma unroll
    for (int i = 0; i < 32; ++i) { const int kk = 2 * i + (lane >> 5); scr[kk * 33 + (lane & 31)] = t.gain ? w[i] * t.gain[t.k0 + kk] : w[i]; }
    LDS_WAIT(); asm volatile("" ::: "memory");
    const int c = lane & 7;
#pragma unroll
    for (int j = 0; j < 4; ++j) { const int n = (lane >> 3) + 8 * j; const LAS float* s = scr + (8 * c) * 33 + n;
        v4u o; o.x = pk2(s[0 * 33], s[1 * 33]); o.y = pk2(s[2 * 33], s[3 * 33]); o.z = pk2(s[4 * 33], s[5 * 33]); o.w = pk2(s[6 * 33], s[7 * 33]);
        *(v4u*)(t.WT + (size_t)(t.dst0 + n) * t.K + t.k0 + 8 * c) = o; }
    LDS_WAIT(); asm volatile("" ::: "memory");
}

__device__ __forceinline__ void norm_rows2(const float* x0, const float* x1, const float* nw, const float* sc0, const float* sh0, const float* sc1, const float* sh1, bf16* o0, bf16* o1, int lane) {
    const f32x4* xr0 = (const f32x4*)x0 + lane; const f32x4* xr1 = (const f32x4*)x1 + lane;
    f32x4 v0[4], v1[4]; float s0 = 0.f, s1 = 0.f;
#pragma unroll
    for (int j = 0; j < 4; ++j) { v0[j] = xr0[64 * j]; v1[j] = xr1[64 * j]; }
#pragma unroll
    for (int j = 0; j < 4; ++j) { s0 += (v0[j].x * v0[j].x + v0[j].y * v0[j].y) + (v0[j].z * v0[j].z + v0[j].w * v0[j].w); s1 += (v1[j].x * v1[j].x + v1[j].y * v1[j].y) + (v1[j].z * v1[j].z + v1[j].w * v1[j].w); }
#pragma unroll
    for (int o = 1; o < 64; o <<= 1) { s0 += __shfl_xor(s0, o); s1 += __shfl_xor(s1, o); }
    const float r0 = 1.0f / sqrtf(s0 * (1.0f / 1024.0f) + 1e-6f), r1 = 1.0f / sqrtf(s1 * (1.0f / 1024.0f) + 1e-6f);
    unsigned long long* p0 = (unsigned long long*)o0 + lane; unsigned long long* p1 = (unsigned long long*)o1 + lane;
#pragma unroll
    for (int j = 0; j < 4; ++j) {
        const f32x4 w = ((const f32x4*)nw)[lane + 64 * j];
        const f32x4 a0 = ((const f32x4*)sc0)[lane + 64 * j], b0 = ((const f32x4*)sh0)[lane + 64 * j], a1 = ((const f32x4*)sc1)[lane + 64 * j], b1 = ((const f32x4*)sh1)[lane + 64 * j];
        const f32x4 y0 = v0[j] * r0 * w * (a0 + 1.0f) + b0, y1 = v1[j] * r1 * w * (a1 + 1.0f) + b1;
        p0[64 * j] = (unsigned long long)pk2(y0.x, y0.y) | ((unsigned long long)pk2(y0.z, y0.w) << 32);
        p1[64 * j] = (unsigned long long)pk2(y1.x, y1.y) | ((unsigned long long)pk2(y1.z, y1.w) << 32);
    }
}

constexpr int KVP = 144, KT_BYTES = 2 * 64 * KVP, BUF_BYTES = 2 * KT_BYTES;
constexpr int ATT_SC = 2 * BUF_BYTES, ATT_XS = ATT_SC + 8 * 64 * 4, OSP = 68;
__device__ __forceinline__ int crow(int r, int hi) { return (r & 3) + 8 * (r >> 2) + 4 * hi; }
__device__ __forceinline__ unsigned cvtpk(float lo, float hi) { return pg8::cvt_pk_bf16(lo, hi); }

#define ATT_THR 6.0f
__device__ __forceinline__ float max3f(float a, float b, float c) { float r; asm("v_max3_f32 %0, %1, %2, %3" : "=v"(r) : "v"(a), "v"(b), "v"(c)); return r; }
__device__ __forceinline__ float rowmax32(const f32x16& a, const f32x16& b) {
    float t[16];
#pragma unroll
    for (int r = 0; r < 16; ++r) t[r] = fmaxf(a[r], b[r]);
    float m0 = max3f(t[0], t[1], t[2]), m1 = max3f(t[3], t[4], t[5]);
    m0 = max3f(m0, t[6], t[7]); m1 = max3f(m1, t[8], t[9]); m0 = max3f(m0, t[10], t[11]); m1 = max3f(m1, t[12], t[13]); m0 = max3f(m0, t[14], t[15]);
    return fmaxf(m0, m1);
}
constexpr int ATT_SLOT = 16384, ATT_KR = 0, ATT_VR = 3 * ATT_SLOT, ATT_SC2 = 6 * ATT_SLOT, ATT_XS2 = ATT_SC2 + 8 * 64 * 4;
__device__ __forceinline__ void attn_unit(LAS unsigned char* lds, const bf16* Pq, int m0, const bf16* Kb, const bf16* Vb, int T, bf16* mrg) {
    const int tid = threadIdx.x, lane = tid & 63, r32 = lane & 31, hi = lane >> 5, wid = __builtin_amdgcn_readfirstlane(tid >> 6), kvh = wid >> 2;
    bf16x8 qr[4];
    { const bf16* qp = Pq + (size_t)(m0 + r32) * IN_DIM + wid * 64 + hi * 8;
#pragma unroll
      for (int d0 = 0; d0 < 4; ++d0) qr[d0] = *(const bf16x8*)(qp + d0 * 16); }
    const bf16* ksrc[2]; const bf16* vsrc[2];
#pragma unroll
    for (int i = 0; i < 2; ++i) { const int j = wid + 8 * i, kh = j >> 3, row = 8 * (j & 7) + (lane >> 3), c = (lane & 7) ^ ((row >> 1) & 7);
        ksrc[i] = Kb + ((size_t)(kh * T + row)) * 64 + c * 8; vsrc[i] = Vb + ((size_t)(kh * 64 + row)) * T + c * 8; }
    const int NT = T >> 6;
#define DMA_K(tk, sk) do { _Pragma("unroll") for (int i = 0; i < 2; ++i) \
        __builtin_amdgcn_global_load_lds((const unsigned*)(ksrc[i] + (size_t)(tk) * 64 * 64), (LAS unsigned*)(lds + ATT_KR + (sk) * ATT_SLOT + (wid + 8 * i) * 1024), 16, 0, 0); } while (0)
#define DMA_V(tv, sv) do { _Pragma("unroll") for (int i = 0; i < 2; ++i) \
        __builtin_amdgcn_global_load_lds((const unsigned*)(vsrc[i] + (tv) * 64), (LAS unsigned*)(lds + ATT_VR + (sv) * ATT_SLOT + (wid + 8 * i) * 1024), 16, 0, 0); } while (0)
#define DMA_KV(tk, sk, tv, sv) do { DMA_K(tk, sk); DMA_V(tv, sv); } while (0)
    DMA_KV(0, 0, 0, 0); DMA_KV(1, 1, 0, 0); DMA_KV(2, 2, 1, 1);
    const int pr = (r32 & ~12) | ((r32 & 4) << 1) | ((r32 & 8) >> 1);
    int koffs[4], voffs[4];
#pragma unroll
    for (int d0 = 0; d0 < 4; ++d0) { koffs[d0] = kvh * 8192 + pr * 128 + (((2 * d0 + hi) ^ ((pr >> 1) & 7)) << 4); voffs[d0] = kvh * 8192 + r32 * 128 + (((2 * d0 + hi) ^ ((r32 >> 1) & 7)) << 4); }
    LAS float* sc = (LAS float*)(lds + ATT_SC2) + wid * 64;
    const unsigned ldsb = (unsigned)(uintptr_t)lds;
#define DSR(dst, addr, off) asm volatile("ds_read_b128 %0, %1 offset:%2" : "=v"(dst) : "v"(addr), "i"(off) : "memory")
    asm volatile("s_waitcnt vmcnt(4)" ::: "memory"); __builtin_amdgcn_s_barrier(); asm volatile("" ::: "memory");
    f32x16 o0 = {}, o1 = {}, o2 = {};
    const bf16x8 ones = {16256, 16256, 16256, 16256, 16256, 16256, 16256, 16256};
    f32x16 c0 = {}, c1 = {}, n0, n1;
#pragma unroll
    for (int d0 = 0; d0 < 4; ++d0) {
        const bf16x8 k0 = *(const LAS bf16x8*)(lds + ATT_KR + koffs[d0]), k1 = *(const LAS bf16x8*)(lds + ATT_KR + koffs[d0] + 32 * 128);
        c0 = __builtin_amdgcn_mfma_f32_32x32x16_bf16(k0, qr[d0], c0, 0, 0, 0);
        c1 = __builtin_amdgcn_mfma_f32_32x32x16_bf16(k1, qr[d0], c1, 0, 0, 0);
    }
    asm volatile("s_waitcnt lgkmcnt(0)" ::: "memory"); __builtin_amdgcn_s_barrier(); asm volatile("" ::: "memory");
    float mrun = rowmax32(c0, c1), rmc = 0.f; mrun = fmaxf(mrun, __shfl_xor(mrun, 32));
#pragma unroll
    for (int r = 0; r < 16; ++r) { c0[r] -= mrun; c1[r] -= mrun; }
    int sk1 = 1, sv0 = 0;
#define ATT_ITER(t, MORE, C0, C1, N0, N1) do { \
        const bool dk_ = (t) + 3 < NT, dv_ = (t) + 2 < NT;       \
        { const int skn_ = sk1 == 0 ? 2 : sk1 - 1, svn_ = sv0 == 0 ? 2 : sv0 - 1; if (dk_) DMA_K((t) + 3, skn_); if (dv_) DMA_V((t) + 2, svn_); } \
        if (__any(rmc > ATT_THR)) { \
            const float rmf_ = fmaxf(rmc, __shfl_xor(rmc, 32)); const float dl = fmaxf(rmf_, 0.f), alpha = __builtin_amdgcn_exp2f(-dl); mrun += dl; \
            _Pragma("unroll") for (int r = 0; r < 16; ++r) { C0[r] -= dl; C1[r] -= dl; } \
            if (hi == 0) sc[r32] = alpha; \
            _Pragma("unroll") for (int g = 0; g < 4; ++g) { const f32x4 a4 = *(const LAS f32x4*)(sc + 8 * g + 4 * hi); \
                _Pragma("unroll") for (int i = 0; i < 4; ++i) { o0[4 * g + i] *= a4[i]; o1[4 * g + i] *= a4[i]; o2[4 * g + i] *= a4[i]; } } \
        } \
        bf16x8 kf_[8], vf_[8]; \
        { const unsigned kb_ = ldsb + ATT_KR + sk1 * ATT_SLOT, vb_ = ldsb + ATT_VR + sv0 * ATT_SLOT; \
          if (MORE) { _Pragma("unroll") for (int d0 = 0; d0 < 4; ++d0) { DSR(kf_[2 * d0], kb_ + koffs[d0], 0); DSR(kf_[2 * d0 + 1], kb_ + koffs[d0], 4096); } } \
          _Pragma("unroll") for (int s4 = 0; s4 < 2; ++s4) { DSR(vf_[2 * s4], vb_ + voffs[s4], 0); DSR(vf_[2 * s4 + 1], vb_ + voffs[s4], 4096); } \
          asm volatile("s_waitcnt lgkmcnt(4)" ::: "memory"); __builtin_amdgcn_sched_barrier(0);        \
          _Pragma("unroll") for (int s4 = 2; s4 < 4; ++s4) { DSR(vf_[2 * s4], vb_ + voffs[s4], 0); DSR(vf_[2 * s4 + 1], vb_ + voffs[s4], 4096); } } \
        if (MORE) { f32x16 negm; _Pragma("unroll") for (int r = 0; r < 16; ++r) negm[r] = -mrun; \
              _Pragma("unroll") for (int d0 = 0; d0 < 4; ++d0) { \
              N0 = __builtin_amdgcn_mfma_f32_32x32x16_bf16(kf_[2 * d0], qr[d0], d0 == 0 ? negm : N0, 0, 0, 0); \
              N1 = __builtin_amdgcn_mfma_f32_32x32x16_bf16(kf_[2 * d0 + 1], qr[d0], d0 == 0 ? negm : N1, 0, 0, 0); } } \
        _Pragma("unroll") for (int r = 0; r < 16; ++r) { C0[r] = __builtin_amdgcn_exp2f(C0[r]); C1[r] = __builtin_amdgcn_exp2f(C1[r]); } \
        v4u pw[4]; \
        _Pragma("unroll") for (int s2 = 0; s2 < 2; ++s2) { \
            pw[s2]     = (v4u){cvtpk(C0[8 * s2], C0[8 * s2 + 1]), cvtpk(C0[8 * s2 + 2], C0[8 * s2 + 3]), cvtpk(C0[8 * s2 + 4], C0[8 * s2 + 5]), cvtpk(C0[8 * s2 + 6], C0[8 * s2 + 7])}; \
            pw[2 + s2] = (v4u){cvtpk(C1[8 * s2], C1[8 * s2 + 1]), cvtpk(C1[8 * s2 + 2], C1[8 * s2 + 3]), cvtpk(C1[8 * s2 + 4], C1[8 * s2 + 5]), cvtpk(C1[8 * s2 + 6], C1[8 * s2 + 7])}; } \
        asm volatile("s_waitcnt lgkmcnt(0)" ::: "memory"); __builtin_amdgcn_sched_barrier(0); \
        _Pragma("unroll") for (int s4 = 0; s4 < 4; ++s4) { \
            o0 = __builtin_amdgcn_mfma_f32_32x32x16_bf16(__builtin_bit_cast(bf16x8, pw[s4]), vf_[2 * s4], o0, 0, 0, 0); \
            o1 = __builtin_amdgcn_mfma_f32_32x32x16_bf16(__builtin_bit_cast(bf16x8, pw[s4]), vf_[2 * s4 + 1], o1, 0, 0, 0); \
            o2 = __builtin_amdgcn_mfma_f32_32x32x16_bf16(__builtin_bit_cast(bf16x8, pw[s4]), ones, o2, 0, 0, 0); } \
        rmc = MORE ? rowmax32(N0, N1) : 0.f; \
        sk1 = sk1 == 2 ? 0 : sk1 + 1; sv0 = sv0 == 2 ? 0 : sv0 + 1; \
        if (dk_) asm volatile("s_waitcnt vmcnt(4)" ::: "memory"); else if (dv_) asm volatile("s_waitcnt vmcnt(2)" ::: "memory"); else asm volatile("s_waitcnt vmcnt(0)" ::: "memory");     \
        asm volatile("s_waitcnt lgkmcnt(0)" ::: "memory"); __builtin_amdgcn_s_barrier(); asm volatile("" ::: "memory"); \
    } while (0)
    int t = 0;
    for (; t < NT - 2; t += 2) {
        ATT_ITER(t, true, c0, c1, n0, n1);
        ATT_ITER(t + 1, true, n0, n1, c0, c1);
    }
    ATT_ITER(t, true, c0, c1, n0, n1);
    ATT_ITER(t + 1, false, n0, n1, c0, c1);
#undef ATT_ITER
#undef DMA_KV
#undef DMA_K
#undef DMA_V
#undef DSR
    asm volatile("s_waitcnt vmcnt(0)" ::: "memory"); __builtin_amdgcn_s_barrier(); asm volatile("" ::: "memory");
    LAS float* st = (LAS float*)lds + wid * (32 * OSP);
#pragma unroll
    for (int r = 0; r < 16; ++r) { const float rl = 1.0f / o2[r]; st[crow(r, hi) * OSP + r32] = o0[r] * rl; st[crow(r, hi) * OSP + 32 + r32] = o1[r] * rl; }
    const int q = lane >> 1, hf = lane & 1;
    f32x4 ov[8]; float ss = 0.f;
#pragma unroll
    for (int i = 0; i < 8; ++i) { ov[i] = *(const LAS f32x4*)(st + q * OSP + 32 * hf + 4 * i); ss += (ov[i].x * ov[i].x + ov[i].y * ov[i].y) + (ov[i].z * ov[i].z + ov[i].w * ov[i].w); }
    ss += __shfl_xor(ss, 1);
    LAS float* xs = (LAS float*)(lds + ATT_XS2);
    if (hf == 0) xs[wid * 32 + q] = ss;
    __syncthreads();
    float tot = 0.f;
#pragma unroll
    for (int w = 0; w < 8; ++w) tot += xs[w * 32 + q];
    const float rinv = 1.0f / sqrtf(tot * (1.0f / 512.0f) + 1e-6f);
    bf16* op = mrg + (size_t)(m0 + q) * D + wid * 64 + 32 * hf;
#pragma unroll
    for (int i = 0; i < 4; ++i) { const f32x4 a = ov[2 * i] * rinv, b = ov[2 * i + 1] * rinv; v4u w; w.x = pk2(a.x, a.y); w.y = pk2(a.z, a.w); w.z = pk2(b.x, b.y); w.w = pk2(b.z, b.w); *(v4u*)(op + 8 * i) = w; }
    __syncthreads();
}

__device__ __forceinline__ void unpack8(const v4u v, float (&f)[8]) {
#pragma unroll
    for (int i = 0; i < 4; ++i) { f[2 * i] = __builtin_bit_cast(float, v[i] << 16); f[2 * i + 1] = __builtin_bit_cast(float, v[i] & 0xffff0000u); }
}
__device__ __forceinline__ void conv_run6(const bf16* P, const float* cw, int m0, bf16* mrg, int lane) {
    v4u gcr[8], ur[8], gbr[6];
#pragma unroll
    for (int i = 0; i < 8; ++i) { int m = m0 - 1 + i; m = m < 0 ? 0 : (m > M_ALL - 1 ? M_ALL - 1 : m); const bf16* row = P + (size_t)m * IN_DIM + 8 * lane; gcr[i] = *(const v4u*)(row + 1280); ur[i] = *(const v4u*)(row + 1792); }
#pragma unroll
    for (int i = 0; i < 6; ++i) gbr[i] = *(const v4u*)(P + (size_t)(m0 + i) * IN_DIM + 8 * lane + 768);
    float w0[8], w1[8], w2[8];
#pragma unroll
    for (int i = 0; i < 8; ++i) { w0[i] = cw[8 * lane + i]; w1[i] = cw[512 + 8 * lane + i]; w2[i] = cw[1024 + 8 * lane + i]; }
    float z[8][8];
#pragma unroll
    for (int i = 0; i < 8; ++i) { float a[8], b[8]; unpack8(gcr[i], a); unpack8(ur[i], b);
#pragma unroll
        for (int c = 0; c < 8; ++c) z[i][c] = a[c] * b[c]; }
#pragma unroll
    for (int t = 0; t < 6; ++t) {
        const int m = m0 + t; const int s = m < M_CTX ? (m & 255) : ((m - M_CTX) & 1023), L = m < M_CTX ? 256 : 1024;
        const float fp = s > 0 ? 1.0f : 0.0f, fn = s < L - 1 ? 1.0f : 0.0f;
        float g[8], y[8]; unpack8(gbr[t], g); float ss = 0.f;
#pragma unroll
        for (int c = 0; c < 8; ++c) { y[c] = g[c] * (w0[c] * fp * z[t][c] + w1[c] * z[t + 1][c] + w2[c] * fn * z[t + 2][c]); ss += y[c] * y[c]; }
        const float rinv = 1.0f / sqrtf(wave_sum(ss) * (1.0f / 512.0f) + 1e-6f);
        v4u o; o.x = pk2(y[0] * rinv, y[1] * rinv); o.y = pk2(y[2] * rinv, y[3] * rinv); o.z = pk2(y[4] * rinv, y[5] * rinv); o.w = pk2(y[6] * rinv, y[7] * rinv);
        *(v4u*)(mrg + (size_t)m * D + 512 + 8 * lane) = o;
    }
}

#define XB_TMO      128
#define XB_XCNT(j)  (256  + 64 * (j))
#define XB_XSUB(j)  (1280 + 64 * (j))
#define XB_XGEN(j)  (2304 + 64 * (j))
#define XB_TOP      3328
#define XB_TOPGEN   3392
#define XCD_BAR_WORDS 3456
#define XB_SPIN_CAP (1u << 18)

__device__ __forceinline__ unsigned xb_ld(unsigned* p)              { return __hip_atomic_load(p, __ATOMIC_RELAXED, __HIP_MEMORY_SCOPE_AGENT); }
__device__ __forceinline__ unsigned xb_add(unsigned* p, unsigned v) { return __hip_atomic_fetch_add(p, v, __ATOMIC_RELAXED, __HIP_MEMORY_SCOPE_AGENT); }
__device__ __forceinline__ unsigned xb_xcc_id() { return (unsigned)__builtin_amdgcn_s_getreg((3 << 11) | 20) & 0xFu; }
#define XB_SPIN(cond, bar) do { unsigned _sp = 0; while (cond) { __builtin_amdgcn_s_sleep(1); \
    if ((++_sp & 255u) == 0u) { if (xb_ld(&(bar)[XB_TMO])) break; if (_sp > XB_SPIN_CAP) { atomicAdd(&(bar)[XB_TMO], 1u); break; } } } } while (0)

struct XcdBarrier {
    unsigned* bar; unsigned x;
    volatile LAS unsigned* st;
};

__device__ __forceinline__ XcdBarrier xcd_barrier_post(unsigned* bar, volatile LAS unsigned* st) {
    XcdBarrier b; b.bar = bar; b.x = xb_xcc_id(); b.st = st;
    if (threadIdx.x == 0) (void)xb_add(&bar[XB_XCNT(b.x)], 1u);
    return b;
}
__device__ __forceinline__ void xcd_barrier_complete(unsigned* bar, unsigned x, unsigned& nloc, unsigned& nx) {
    const unsigned G = gridDim.x * gridDim.y * gridDim.z;
    unsigned sum, cnt, mine, sp = 0u;
    for (;;) {
        sum = 0u; cnt = 0u; mine = 0u;
#pragma unroll
        for (unsigned j = 0; j < 16; ++j) { const unsigned c = xb_ld(&bar[XB_XCNT(j)]); sum += c; cnt += (c > 0u) ? 1u : 0u; mine = (j == x) ? c : mine; }
        if (sum == G) break;
        __builtin_amdgcn_s_sleep(1);
        if ((++sp & 255u) == 0u) { if (xb_ld(&bar[XB_TMO])) break; if (sp > XB_SPIN_CAP) { atomicAdd(&bar[XB_TMO], 1u); break; } }
    }
    nloc = mine > 0u ? mine : 1u; nx = cnt > 0u ? cnt : 1u;
}

__device__ __forceinline__ void xcd_barrier(const XcdBarrier& b) {
    asm volatile("s_waitcnt vmcnt(0)" ::: "memory");
    __syncthreads();
    if (threadIdx.x == 0) {
        unsigned* bar = b.bar;
        __builtin_amdgcn_s_waitcnt(0);
        unsigned nloc = b.st[0], nx = b.st[1];
        if (nloc == 0u) { xcd_barrier_complete(bar, b.x, nloc, nx); b.st[0] = nloc; b.st[1] = nx; }
        const unsigned old = xb_add(&bar[XB_XSUB(b.x)], 1u);
        const unsigned gen = old / nloc;
        if (old + 1u == (gen + 1u) * nloc) {
            __builtin_amdgcn_fence(__ATOMIC_RELEASE, "agent");
            asm volatile("s_waitcnt vmcnt(0)" ::: "memory");
            const unsigned og = xb_add(&bar[XB_TOP], 1u);
            const unsigned tg = og / nx;
            if (og + 1u == (tg + 1u) * nx) xb_add(&bar[XB_TOPGEN], 1u);
            else XB_SPIN(xb_ld(&bar[XB_TOPGEN]) == tg, bar);
            __builtin_amdgcn_fence(__ATOMIC_ACQUIRE, "agent");
            xb_add(&bar[XB_XGEN(b.x)], 1u);
            asm volatile("s_waitcnt vmcnt(0)" ::: "memory");
        } else {
            XB_SPIN(xb_ld(&bar[XB_XGEN(b.x)]) == gen, bar);
            __builtin_amdgcn_fence(__ATOMIC_ACQUIRE, "agent");
            asm volatile("s_waitcnt vmcnt(0)" ::: "memory");
        }
    }
    __syncthreads();
}

__global__ void __launch_bounds__(NTHREADS, 2) fwd_kernel(Args a) {
    extern __shared__ __attribute__((aligned(16))) unsigned char lds_raw[];
    LAS unsigned char* lds = (LAS unsigned char*)lds_raw;
    cg::grid_group grid = cg::this_grid();
    const int tid = threadIdx.x, lane = tid & 63, wave = __builtin_amdgcn_readfirstlane(tid >> 6);
    const int G = gridDim.x, bx = blockIdx.x;
    const int vcu = (G % 8 == 0) ? (bx % 8) * (G / 8) + bx / 8 : bx;
    unsigned char* ws = a.ws;
    float* mod = (float*)(ws + WS_MOD); float* rope = (float*)(ws + WS_ROPE);
    bf16* Win = (bf16*)(ws + WS_WIN); bf16* Wout = (bf16*)(ws + WS_WOUT); bf16* Wgu = (bf16*)(ws + WS_WGU); bf16* Wdn = (bf16*)(ws + WS_WDN);
    bf16* Kl = (bf16*)(ws + WS_KL); bf16* Vl = (bf16*)(ws + WS_VL); bf16* Kc = (bf16*)(ws + WS_KC); bf16* Vc = (bf16*)(ws + WS_VC);
    bf16* H = (bf16*)(ws + WS_H); bf16* P = (bf16*)(ws + WS_P); bf16* MRG = (bf16*)(ws + WS_MRG); bf16* ACT = (bf16*)(ws + WS_ACT); float* X1 = a.out;
    float* newk = a.out + (size_t)M_ALL * D; float* newv = newk + 16 * 256 * 128;
    const int lo = a.ph_lo, hi = a.ph_hi;
#define IN(k) (lo <= (k) && (k) < hi)
#define SEAM(k) do { if (IN(k) && IN((k) + 1)) xcd_barrier(bar); } while (0)
    volatile LAS unsigned* misc = (volatile LAS unsigned*)(lds + LDS_BYTES - 256);
    if (tid < 64) misc[tid] = 0u;
    __syncthreads();
    XcdBarrier bar = xcd_barrier_post((unsigned*)ws + a.li * XCD_BAR_WORDS, misc);
    if (a.ph_lo < 0) grid.sync();

    if (IN(0)) {
        if (bx < 96) {
            LAS float* sl = (LAS float*)lds;
            for (int i = tid; i < 9 * 1024; i += NTHREADS) { const float v = i < 8192 ? a.c[i] : a.c_ctx[i - 8192]; sl[i] = v / (1.0f + __expf(-v)); }
            __syncthreads();
            const int cgp = lane & 15, ks = lane >> 4;
            f32x4 acc[9];
#pragma unroll
            for (int r = 0; r < 9; ++r) acc[r] = (f32x4){0.f, 0.f, 0.f, 0.f};
            const float* wp = a.w_ada + (size_t)(128 * wave + ks) * MODW + 64 * bx + 4 * cgp;
#pragma unroll 1
            for (int i0 = 0; i0 < 32; i0 += 16) {
                f32x4 w[16];
#pragma unroll
                for (int j = 0; j < 16; ++j) w[j] = __builtin_nontemporal_load((const f32x4*)(wp + (size_t)(4 * (i0 + j)) * MODW));
#pragma unroll
                for (int j = 0; j < 16; ++j) { const int k = 128 * wave + 4 * (i0 + j) + ks;
#pragma unroll
                    for (int r = 0; r < 9; ++r) acc[r] += w[j] * sl[r * 1024 + k]; }
            }
            LAS float* red = (LAS float*)(lds + 40960);
#pragma unroll
            for (int r = 0; r < 9; ++r) {
#pragma unroll
                for (int j = 0; j < 4; ++j) { float v = acc[r][j]; v += __shfl_xor(v, 16); v += __shfl_xor(v, 32); acc[r][j] = v; }
                if (ks == 0) *(LAS f32x4*)(red + (wave * 9 + r) * 64 + 4 * cgp) = acc[r];
            }
            __syncthreads();
            for (int i = tid; i < 9 * 64; i += NTHREADS) { const int r = i >> 6, l = i & 63; float s = a.b_ada[64 * bx + l];
#pragma unroll
                for (int w = 0; w < 8; ++w) s += red[(w * 9 + r) * 64 + l];
                mod[r * MODW + 64 * bx + l] = s; }
            __syncthreads();
        }
        {
            LAS float* scr = (LAS float*)(lds + wave * 17408);
            const int gw = bx * NWAVES + wave, NGW = G * NWAVES;
            constexpr int I_IN = 16 * 72, I_OUT = 16 * 32, I_GU = 16 * 176, I_DN = 44 * 32;
            const bool bal = (G == 256);
            const int nhere = bal ? I_IN + I_OUT + I_DN : I_IN + I_OUT + I_DN + I_GU;
            const int nit = bal ? (bx < 96 ? 0 : ((bx - 96) * NWAVES + wave < 512 ? 3 : 2)) : (nhere - gw + NGW - 1) / NGW;
            auto decode = [&](int ii) -> TrItem {
                const int it = bal ? (bx - 96) * NWAVES + wave + 1280 * ii : gw + ii * NGW;
                int r = it; TrItem t;
                if (r < I_IN) { const int kb = r / 72, db = r % 72, pn = db >> 3, bj = (db >> 2) & 1, wc = db & 3; const int src = pn < 3 ? 64 * (4 * pn + wc) + 32 * bj : 32 * db;
                    t = TrItem{a.w_in, IN_DIM, src, D, 64 * kb, Win, 32 * db, nullptr}; return t; } r -= I_IN;
                if (r < I_OUT) { const int kb = r / 32, db = r % 32; t = TrItem{a.w_out, D, 32 * db, D, 64 * kb, Wout, 32 * db, kb < 8 ? a.aon : a.con - 512}; return t; } r -= I_OUT;
                if (r < I_DN) { const int kb = r / 32, db = r % 32; t = TrItem{a.w_dn, D, 32 * db, D_FF, 64 * kb, Wdn, 32 * db, nullptr}; return t; } r -= I_DN;
                { const int kb = r / 176, db = r % 176, pn = db >> 3, bj = (db >> 2) & 1, qq = db & 3; const int src = (bj ? D_FF : 0) + 128 * pn + 32 * qq;
                    t = TrItem{a.w_gu, NGU, src, D, 64 * kb, Wgu, 32 * db, nullptr}; return t; }
            };
            int ii = 0;
            if (nit == 3) {
                const TrItem t0 = decode(0), t1 = decode(1), t2 = decode(2);
                float w0[32], w1[32], w2[32];
                tr_load(t0, w0, lane); tr_load(t1, w1, lane); tr_load(t2, w2, lane);
                tr_store(t0, w0, scr, lane); tr_store(t1, w1, scr + 2176, lane); tr_store(t2, w2, scr, lane);
                ii = 3;
            }
            for (; ii + 1 < nit; ii += 2) {
                const TrItem t0 = decode(ii), t1 = decode(ii + 1);
                float w0[32], w1[32];
                tr_load(t0, w0, lane); tr_load(t1, w1, lane);
                tr_store(t0, w0, scr, lane); tr_store(t1, w1, scr + 2176, lane);
            }
            if (ii < nit) { const TrItem t0 = decode(ii); float w0[32]; tr_load(t0, w0, lane); tr_store(t0, w0, scr, lane); }
        }
        {
            const int gt = bx * NTHREADS + tid, NGT = G * NTHREADS;
            for (int i = gt; i < 8 * 256 * 128; i += NGT) { const int d = i & 63, kh = (i >> 6) & 1, key = (i >> 7) & 255, b = i >> 15;
                Kl[((size_t)(b * 2 + kh) * 1280 + key) * 64 + d] = (bf16)f2bf(a.cache_k[i]);
                Vl[((size_t)(b * 2 + kh) * 64 + d) * 1280 + key] = (bf16)f2bf(a.cache_v[i]); }
            if (gt < 1024) { const int pos = gt >> 4, p = gt & 15; const float inv = 1.0f / powf(10000.0f, (float)p / 16.0f); const float ang = (float)pos * inv; rope[gt] = cosf(ang); rope[1024 + gt] = sinf(ang); }
        }
    }
    SEAM(0);
    if (IN(1)) {
        const int gw = vcu * NWAVES + wave, NGW = G * NWAVES;
        for (int m = gw; m < M_ALL; m += 2 * NGW) {
            const int m2 = m + NGW < M_ALL ? m + NGW : m;
            const float* xa = m < M_CTX ? a.xp + (size_t)m * D : a.xs + (size_t)(m - M_CTX) * D;
            const float* xb = m2 < M_CTX ? a.xp + (size_t)m2 * D : a.xs + (size_t)(m2 - M_CTX) * D;
            const float* ma = mod + (size_t)(m < M_CTX ? 8 : (m - M_CTX) >> 10) * MODW;
            const float* mb = mod + (size_t)(m2 < M_CTX ? 8 : (m2 - M_CTX) >> 10) * MODW;
            norm_rows2(xa, xb, a.norm_mix, ma + 1024, ma, mb + 1024, mb, H + (size_t)m * D, H + (size_t)m2 * D, lane);
        }
    }
    SEAM(1);
    if (IN(2)) {
        pg8::Gemm g{H, Win, M_ALL, IN_DIM, D}; pg8::StaticOrder S; S.init(M_ALL, IN_DIM, G, bx);
        pg8::EpiIn E{P, Kl, Vl, Kc, Vc, newk, newv, a.q_norm, a.k_norm, rope};
        pg8::gemm_phase<pg8::EpiIn, pg8::StaticOrder, true, true>(lds, g, S, E);
        if (G == 256 && bx >= 176) {
            LAS float* scr = (LAS float*)(lds + wave * 17408);
            constexpr int I_GU = 16 * 176;
            for (int it = (bx - 176) * NWAVES + wave; it < I_GU; it += 2 * 80 * NWAVES) {
                const int it2 = it + 80 * NWAVES;
                auto dec = [&](int r) -> TrItem { const int kb = r / 176, db = r % 176, pn = db >> 3, bj = (db >> 2) & 1, qq = db & 3; const int src = (bj ? D_FF : 0) + 128 * pn + 32 * qq; return TrItem{a.w_gu, NGU, src, D, 64 * kb, Wgu, 32 * db, nullptr}; };
                const TrItem t0 = dec(it); float w0[32]; tr_load(t0, w0, lane);
                if (it2 < I_GU) { const TrItem t1 = dec(it2); float w1[32]; tr_load(t1, w1, lane); tr_store(t0, w0, scr, lane); tr_store(t1, w1, scr + 2176, lane); }
                else tr_store(t0, w0, scr, lane);
            }
        }
    }
    SEAM(2);
    if (IN(3)) {
        for (int u = vcu; u < 384; u += G) {
            if (u < 256) { const int b = u >> 5, qb = u & 31; attn_unit(lds, P, M_CTX + b * 1024 + qb * 32, Kl + (size_t)b * 2 * 1280 * 64, Vl + (size_t)b * 2 * 64 * 1280, 1280, MRG); }
            else { const int b = (u - 256) >> 3, qb = (u - 256) & 7; attn_unit(lds, P, b * 256 + qb * 32, Kc + (size_t)b * 2 * 256 * 64, Vc + (size_t)b * 2 * 64 * 256, 256, MRG); }
        }
        const int gw = vcu * NWAVES + wave, NGW = G * NWAVES;
        if (G == 256) { if (vcu >= 128) { const int w2 = (vcu - 128) * NWAVES + wave; conv_run6(P, a.conv_w, 6 * w2, MRG, lane); conv_run6(P, a.conv_w, 6 * (w2 + 1024), MRG, lane); } }
        else for (int r = gw; r < M_ALL / 6; r += NGW) conv_run6(P, a.conv_w, 6 * r, MRG, lane);
    }
    SEAM(3);
    if (IN(4)) {
        pg8::Gemm g{MRG, Wout, M_ALL, D, D}; pg8::StaticOrder S; S.init(M_ALL, D, G, bx, 192);
        pg8::EpiRes3 E{a.xp, a.xs, X1, mod + 2048, false};
        pg8::gemm_phase<pg8::EpiRes3, pg8::StaticOrder, true, true>(lds, g, S, E);
    }
    SEAM(4);
    if (IN(5)) {
        const int gw = vcu * NWAVES + wave, NGW = G * NWAVES;
        for (int m = gw; m < M_ALL; m += 2 * NGW) {
            const int m2 = m + NGW < M_ALL ? m + NGW : m;
            const float* ma = mod + (size_t)(m < M_CTX ? 8 : (m - M_CTX) >> 10) * MODW;
            const float* mb = mod + (size_t)(m2 < M_CTX ? 8 : (m2 - M_CTX) >> 10) * MODW;
            norm_rows2(X1 + (size_t)m * D, X1 + (size_t)m2 * D, a.norm_ffn, ma + 4096, ma + 3072, mb + 4096, mb + 3072, H + (size_t)m * D, H + (size_t)m2 * D, lane);
        }
    }
    SEAM(5);
    if (IN(6)) {
        pg8::Gemm g{H, Wgu, M_ALL, NGU, D}; pg8::StaticOrder S; S.init(M_ALL, NGU, G, bx, 192);
        pg8::EpiSwiGLU3 E{ACT, D_FF};
        pg8::gemm_phase<pg8::EpiSwiGLU3, pg8::StaticOrder, true, true>(lds, g, S, E);
    }
    SEAM(6);
    if (IN(7)) {
        pg8::Gemm g{ACT, Wdn, M_ALL, D, D_FF}; pg8::StaticOrder S; S.init(M_ALL, D, G, bx, 192);
        pg8::EpiRes3 E{X1, X1 + (size_t)M_CTX * D, a.out, mod + 5120, true};
        pg8::gemm_phase<pg8::EpiRes3, pg8::StaticOrder, true, true>(lds, g, S, E);
    }
#undef IN
#undef SEAM
}

#ifndef MK_N_LAUNCHES
#define MK_N_LAUNCHES 1
#endif
extern "C" void kernel_launch(void* const* d_in, const int* in_sizes, int n_in, void* d_out, int out_size, void* d_ws, size_t ws_size, hipStream_t stream) {
    static int grid = 0;
    if (grid == 0) {
        int dev = 0, cus = 0, per_cu = 0;
        hipGetDevice(&dev); hipDeviceGetAttribute(&cus, hipDeviceAttributeMultiprocessorCount, dev);
        if (hipFuncSetAttribute((const void*)fwd_kernel, hipFuncAttributeMaxDynamicSharedMemorySize, LDS_BYTES) != hipSuccess) { fprintf(stderr, "kernel_launch: hipFuncSetAttribute failed\n"); grid = -1; return; }
        hipOccupancyMaxActiveBlocksPerMultiprocessor(&per_cu, (const void*)fwd_kernel, NTHREADS, LDS_BYTES);
        (void)hipGetLastError();
        if (per_cu < 1) { fprintf(stderr, "kernel_launch: occupancy query says %d blocks per CU\n", per_cu); per_cu = 1; }
        grid = cus;
        if (n_in != 19 || ws_size < WS_END) { fprintf(stderr, "kernel_launch: unexpected n_in %d / ws %zu\n", n_in, ws_size); grid = -1; return; }
    }
    if (grid < 0) return;
    Args a{};
    a.xp = (const float*)d_in[0]; a.xs = (const float*)d_in[1]; a.c = (const float*)d_in[2]; a.cache_k = (const float*)d_in[3]; a.cache_v = (const float*)d_in[4]; a.c_ctx = (const float*)d_in[5];
    a.norm_mix = (const float*)d_in[6]; a.norm_ffn = (const float*)d_in[7]; a.w_ada = (const float*)d_in[8]; a.b_ada = (const float*)d_in[9]; a.w_in = (const float*)d_in[10];
    a.q_norm = (const float*)d_in[11]; a.k_norm = (const float*)d_in[12]; a.conv_w = (const float*)d_in[13]; a.aon = (const float*)d_in[14]; a.con = (const float*)d_in[15];
    a.w_out = (const float*)d_in[16]; a.w_gu = (const float*)d_in[17]; a.w_dn = (const float*)d_in[18]; a.out = (float*)d_out; a.ws = (unsigned char*)d_ws;
#if MK_N_LAUNCHES == 1
    (void)hipMemsetAsync(d_ws, 0, 65536, stream);
    void* args[] = {&a};
    if (PROBE_DUP >= 0) {
        a.ph_lo = 0; a.ph_hi = PROBE_DUP > 7 ? 0 : PROBE_DUP + 1;
        (void)hipLaunchCooperativeKernel((const void*)fwd_kernel, dim3(grid), dim3(NTHREADS), args, LDS_BYTES, stream);
        a.ph_lo = PROBE_DUP > 7 ? 0 : PROBE_DUP; a.ph_hi = 8; a.li = 1;
    } else { a.ph_lo = 0; a.ph_hi = 8; }
    hipError_t e = hipLaunchCooperativeKernel((const void*)fwd_kernel, dim3(grid), dim3(NTHREADS), args, LDS_BYTES, stream);
    if (e != hipSuccess) fprintf(stderr, "cooperative launch failed: %s (grid %d)\n", hipGetErrorString(e), grid);
#else
    for (int p = 0; p < 8; ++p) { a.ph_lo = p; a.ph_hi = p + 1; hipLaunchKernelGGL(fwd_kernel, dim3(grid), dim3(NTHREADS), LDS_BYTES, stream, a); }
#endif
}
```

```cpp
#include <hip/hip_runtime.h>
#include <hip/hip_cooperative_groups.h>
#include <cstdio>
#include <cstdint>
namespace cg = cooperative_groups;
#ifndef PROBE_DUP
#define PROBE_DUP -1
#endif
namespace pg8 {
#define PG8_LAS __attribute__((address_space(3)))
typedef unsigned short bf16_t;
typedef short bf16x8 __attribute__((ext_vector_type(8)));
typedef float f32x4 __attribute__((ext_vector_type(4)));
typedef unsigned u32x4 __attribute__((ext_vector_type(4)));
constexpr int BM = 256, BK = 64, HALF = 128, HTB = HALF * BK * 2  , STAGE_BYTES = 8 * HTB, NXCD = 8, WGM = 8;

__host__ __device__ __forceinline__ int lds_byte(int r, int c) { const int st = (r >> 4) * 2 + (c >> 5), rr = r & 15, cc = c & 31, ob = rr * 64 + cc * 2; return st * 1024 + (ob ^ (((ob >> 9) & 1) << 5)); }
__host__ __device__ __forceinline__ void stage_rc(int b, int& R, int& C) { const int st = b / 1024, sb = b % 1024, swz = sb ^ (((sb >> 9) & 1) << 5); R = (st >> 1) * 16 + swz / 64; C = (st & 1) * 32 + (swz % 64) / 2; }
__host__ __device__ __forceinline__ int perm32(int rho) { const int n = rho >> 4, i = rho & 15; return 8 * (i >> 2) + 4 * n + (i & 3); }

struct Unit { int pm, pn; };
struct Gemm { const bf16_t* A; const bf16_t* Bt; int M, N, K; };

struct StaticOrder {
    int nM, nN, nwg, G, c;
    __host__ __device__ void init(int M, int N, int G_, int c_, int bm = BM) { nM = M / bm; nN = N / BM; nwg = nM * nN; G = G_; c = c_; }
    __host__ __device__ bool next(int i, Unit& u) const {
        const long L = (long)i * G + c; if (L >= nwg) return false;
        int wgid = (int)L; { const int q = nwg / NXCD, r = nwg % NXCD, xcd = wgid % NXCD, off = wgid / NXCD; wgid = (xcd < r ? xcd * (q + 1) : r * (q + 1) + (xcd - r) * q) + off; }
        const int nig = WGM * nN, gid = wgid / nig, fm = gid * WGM, gsz = (nM - fm) < WGM ? (nM - fm) : WGM;
        u.pm = fm + ((wgid % nig) % gsz); u.pn = (wgid % nig) / gsz; return true;
    }
    __device__ __forceinline__ void a_ready(const Unit&) const {}
    __device__ __forceinline__ void done(const Unit&) const {}
};
typedef float f32x2cv_t __attribute__((ext_vector_type(2))); typedef __bf16 bf16x2cv_t __attribute__((ext_vector_type(2)));
__device__ __forceinline__ unsigned cvt_pk_bf16(float lo, float hi) { f32x2cv_t v = {lo, hi}; bf16x2cv_t b = __builtin_convertvector(v, bf16x2cv_t); return __builtin_bit_cast(unsigned, b); }
typedef float f32x2 __attribute__((ext_vector_type(2)));
template <class Epi, class Sched, bool ALIGN_EPI = false, bool SP2 = false>
__device__ __forceinline__ void gemm_phase(PG8_LAS unsigned char* lds, const Gemm g, const Sched& S, const Epi& E) {
    const int tid = threadIdx.x, wid = __builtin_amdgcn_readfirstlane(tid >> 6), lane = tid & 63, wr = wid >> 2, wc = wid & 3, fr = lane & 15, fq = lane >> 4;
    const int K = g.K, nt = K / BK;
    unsigned voffA[2], voffB[2];
#pragma unroll
    for (int i = 0; i < 2; ++i) { int R, C; stage_rc(tid * 16 + i * 8192, R, C); const int Rb = Epi::PERM ? ((R & ~31) + perm32(R & 31)) : R;
        voffA[i] = (unsigned)(R * K + C) * 2u; voffB[i] = (unsigned)(Rb * K + C) * 2u; }
    const size_t kstep = (size_t)(BK * 2);
    constexpr int MT = Epi::MT, HA = 32 * MT;
    const size_t hstepA = (size_t)HA * K * 2, hstep = (size_t)HALF * K * 2;
    const size_t tstepA = 2 * hstepA, tstep = 2 * hstep;
    const unsigned ldsw = (unsigned)wid * 1024u;
    const int aoff = lds_byte(wr * (16 * MT) + fr, fq * 8), boff = lds_byte(wc * 32 + fr, fq * 8);
#define PG8_SA(b, h) (((b) * 2 + (h)) * HTB)
#define PG8_SB(b, h) ((4 + (b) * 2 + (h)) * HTB)
#define PG8_STAGE(bufoff, gbase, voff) do { _Pragma("unroll") for (int _i = 0; _i < 2; ++_i) \
        __builtin_amdgcn_global_load_lds((const unsigned*)((const char*)(gbase) + (voff)[_i]), (PG8_LAS unsigned*)(lds + (bufoff) + ldsw + _i * 8192), 16, 0, 0); } while (0)
#define PG8_LDA(dst, b, h) do { _Pragma("unroll") for (int m = 0; m < MT; ++m) _Pragma("unroll") for (int k = 0; k < 2; ++k) dst[m][k] = *(const PG8_LAS bf16x8*)(lds + PG8_SA(b, h) + aoff + m * 2048 + k * 1024); } while (0)
#define PG8_LDB(dst, b, h) do { _Pragma("unroll") for (int n = 0; n < 2; ++n) _Pragma("unroll") for (int k = 0; k < 2; ++k) dst[n][k] = *(const PG8_LAS bf16x8*)(lds + PG8_SB(b, h) + boff + n * 2048 + k * 1024); } while (0)
#define PG8_MMA(ai, bj, At, Bt) do { __builtin_amdgcn_s_setprio(1); _Pragma("unroll") for (int m = 0; m < MT; ++m) _Pragma("unroll") for (int n = 0; n < 2; ++n) _Pragma("unroll") for (int k = 0; k < 2; ++k) \
        acc[ai][bj][m][n] = __builtin_amdgcn_mfma_f32_16x16x32_bf16(Bt[n][k], At[m][k], acc[ai][bj][m][n], 0, 0, 0); __builtin_amdgcn_s_setprio(0); } while (0)
#define PG8_WAIT_V(n) asm volatile("s_waitcnt vmcnt(" #n ")" ::: "memory")
#define PG8_WAIT_L(n) asm volatile("s_waitcnt lgkmcnt(" #n ")" ::: "memory")
#define PG8_BAR __builtin_amdgcn_s_barrier()
#define PG8_SCHED __builtin_amdgcn_sched_barrier(0)
    Unit cur, nxt; int ui = 0;
    if (!S.next(0, cur)) return;
    f32x4 acc[2][2][MT][2];
#pragma unroll
    for (int a = 0; a < 2; ++a)
#pragma unroll
        for (int b = 0; b < 2; ++b)
#pragma unroll
            for (int m = 0; m < MT; ++m)
#pragma unroll
                for (int n = 0; n < 2; ++n) acc[a][b][m][n] = (f32x4){0.f, 0.f, 0.f, 0.f};
    bf16x8 At[MT][2], B0[2][2], B1[2][2];
    const char* cA = (const char*)g.A + (size_t)cur.pm * tstepA; const char* cB = (const char*)g.Bt + (size_t)cur.pn * tstep;
    S.a_ready(cur);
    if constexpr (SP2) {
        PG8_STAGE(PG8_SB(0, 0), cB, voffB); PG8_STAGE(PG8_SB(0, 1), cB + hstep, voffB); PG8_STAGE(PG8_SA(0, 0), cA, voffA); PG8_STAGE(PG8_SA(0, 1), cA + hstepA, voffA);
        if (wr == 1) PG8_BAR;
        PG8_WAIT_V(2); PG8_BAR;
        PG8_STAGE(PG8_SB(1, 0), cB + kstep, voffB); PG8_STAGE(PG8_SA(1, 0), cA + kstep, voffA); PG8_STAGE(PG8_SB(1, 1), cB + hstep + kstep, voffB);
        PG8_WAIT_V(6); PG8_BAR;
    } else {
        PG8_STAGE(PG8_SB(0, 0), cB, voffB); PG8_STAGE(PG8_SA(0, 0), cA, voffA); PG8_STAGE(PG8_SB(0, 1), cB + hstep, voffB); PG8_STAGE(PG8_SA(0, 1), cA + hstepA, voffA);
        if (wr == 1) PG8_BAR;
        PG8_WAIT_V(4); PG8_BAR;
        PG8_STAGE(PG8_SB(1, 0), cB + kstep, voffB); PG8_STAGE(PG8_SA(1, 0), cA + kstep, voffA); PG8_STAGE(PG8_SB(1, 1), cB + hstep + kstep, voffB);
        PG8_WAIT_V(6); PG8_BAR;
    }
    for (;;) {
        const bool has_next = S.next(ui + 1, nxt);
        const char* nA = has_next ? (const char*)g.A + (size_t)nxt.pm * tstepA : cA; const char* nB = has_next ? (const char*)g.Bt + (size_t)nxt.pn * tstep : cB;
        for (int t = 0; t < nt; t += 2) {
            const bool last = (t == nt - 2);
            const char* a1 = cA + (size_t)(t + 1) * kstep;
            const char* a2 = last ? nA : cA + (size_t)(t + 2) * kstep; const char* b2 = last ? nB : cB + (size_t)(t + 2) * kstep;
            const char* a3 = a2 + kstep; const char* b3 = b2 + kstep;
            if (last && has_next) S.a_ready(nxt);
            if constexpr (SP2) {
            PG8_LDB(B0, 0, 0); PG8_LDB(B1, 0, 1); PG8_SCHED; PG8_LDA(At, 0, 0); PG8_STAGE(PG8_SA(1, 1), a1 + hstepA, voffA);
            PG8_WAIT_V(8); PG8_WAIT_L(0); PG8_BAR; PG8_MMA(0, 0, At, B0); PG8_MMA(0, 1, At, B1); PG8_BAR; PG8_SCHED;
            PG8_LDA(At, 0, 1); PG8_STAGE(PG8_SB(0, 0), b2, voffB); PG8_STAGE(PG8_SB(0, 1), b2 + hstep, voffB); PG8_STAGE(PG8_SA(0, 0), a2, voffA);
            PG8_WAIT_V(8); PG8_WAIT_L(0); PG8_BAR; PG8_MMA(1, 0, At, B0); PG8_MMA(1, 1, At, B1); PG8_BAR; PG8_SCHED;
            PG8_LDB(B0, 1, 0); PG8_LDB(B1, 1, 1); PG8_SCHED; PG8_LDA(At, 1, 0); PG8_STAGE(PG8_SA(0, 1), a2 + hstepA, voffA);
            PG8_WAIT_V(8); PG8_WAIT_L(0); PG8_BAR; PG8_MMA(0, 0, At, B0); PG8_MMA(0, 1, At, B1); PG8_BAR; PG8_SCHED;
            PG8_LDA(At, 1, 1); PG8_STAGE(PG8_SB(1, 0), b3, voffB); PG8_STAGE(PG8_SB(1, 1), b3 + hstep, voffB); PG8_STAGE(PG8_SA(1, 0), a3, voffA);
            PG8_WAIT_V(8); PG8_WAIT_L(0); PG8_BAR; PG8_MMA(1, 0, At, B0); PG8_MMA(1, 1, At, B1); PG8_BAR; PG8_SCHED;
            } else {
            PG8_LDB(B0, 0, 0); PG8_SCHED; PG8_LDA(At, 0, 0); PG8_STAGE(PG8_SA(1, 1), a1 + hstepA, voffA);
            PG8_WAIT_L(8); PG8_BAR; PG8_WAIT_L(0); PG8_MMA(0, 0, At, B0); PG8_BAR; PG8_SCHED;
            PG8_LDB(B1, 0, 1); PG8_STAGE(PG8_SB(0, 0), b2, voffB);
            PG8_BAR; PG8_WAIT_L(0); PG8_MMA(0, 1, At, B1); PG8_BAR;
            PG8_LDA(At, 0, 1); PG8_STAGE(PG8_SA(0, 0), a2, voffA);
            PG8_BAR; PG8_WAIT_L(0); PG8_MMA(1, 0, At, B0); PG8_BAR; PG8_SCHED;
            PG8_STAGE(PG8_SB(0, 1), b2 + hstep, voffB);
            PG8_WAIT_V(6); PG8_BAR; PG8_MMA(1, 1, At, B1); PG8_BAR;
            PG8_LDB(B0, 1, 0); PG8_SCHED; PG8_LDA(At, 1, 0); PG8_STAGE(PG8_SA(0, 1), a2 + hstepA, voffA);
            PG8_WAIT_L(8); PG8_BAR; PG8_WAIT_L(0); PG8_MMA(0, 0, At, B0); PG8_BAR; PG8_SCHED;
            PG8_LDB(B1, 1, 1); PG8_STAGE(PG8_SB(1, 0), b3, voffB);
            PG8_BAR; PG8_WAIT_L(0); PG8_MMA(0, 1, At, B1); PG8_BAR;
            PG8_LDA(At, 1, 1); PG8_STAGE(PG8_SA(1, 0), a3, voffA);
            PG8_BAR; PG8_WAIT_L(0); PG8_MMA(1, 0, At, B0); PG8_BAR; PG8_SCHED;
            PG8_STAGE(PG8_SB(1, 1), b3 + hstep, voffB);
            PG8_WAIT_V(6); PG8_BAR; PG8_MMA(1, 1, At, B1); PG8_BAR;
            }
        }
        if constexpr (ALIGN_EPI) { if (wr == 0) PG8_BAR; }
        if constexpr (!Epi::AFTER_DRAIN) { E(acc, cur, wr, wc, fr, fq); S.done(cur); }
        if (!has_next) break;
#pragma unroll
        for (int a = 0; a < 2; ++a)
#pragma unroll
            for (int b = 0; b < 2; ++b)
#pragma unroll
                for (int m = 0; m < MT; ++m)
#pragma unroll
                    for (int n = 0; n < 2; ++n) acc[a][b][m][n] = (f32x4){0.f, 0.f, 0.f, 0.f};
        cur = nxt; cA = nA; cB = nB; ++ui;
        if constexpr (ALIGN_EPI) { if (wr == 1) PG8_BAR; }
    }
    PG8_WAIT_V(0);
    if constexpr (!ALIGN_EPI) { if (wr == 0) PG8_BAR; }
    PG8_BAR;
    if constexpr (Epi::AFTER_DRAIN) { E.fused(acc, cur, wr, wc, fr, fq, lds, wid, lane); S.done(cur); }
#undef PG8_SA
#undef PG8_SB
#undef PG8_STAGE
#undef PG8_LDA
#undef PG8_LDB
#undef PG8_MMA
#undef PG8_WAIT_V
#undef PG8_WAIT_L
#undef PG8_BAR
#undef PG8_SCHED
}
constexpr int TOK_CTX = 4096, TOK_ALL = 12288, PITCH_P = 2304;
constexpr float RMS_EPS_F = 1e-6f;
constexpr float QSCALE = 0.125f * 1.4426950408889634f;
__device__ __forceinline__ u32x4 pack8(const f32x4 a, const f32x4 b) { u32x4 w; w.x = cvt_pk_bf16(a[0], a[1]); w.y = cvt_pk_bf16(a[2], a[3]); w.z = cvt_pk_bf16(b[0], b[1]); w.w = cvt_pk_bf16(b[2], b[3]); return w; }
__device__ __forceinline__ unsigned short bf1(float f) { return (unsigned short)(cvt_pk_bf16(f, 0.f) & 0xffffu); }

struct EpiIn {
    static constexpr bool PERM = true, AFTER_DRAIN = false; static constexpr int MT = 4;
    bf16_t* P; bf16_t* Kl; bf16_t* Vl; bf16_t* Kc; bf16_t* Vc; float* newk; float* newv; const float* qn; const float* kn; const float* rope;
    __device__ __forceinline__ void operator()(const f32x4 (&acc)[2][2][4][2], const Unit& u, int wr, int wc, int fr, int fq) const {
        const int row0 = u.pm * BM + wr * 64 + fr;
        if (u.pn >= 3) {
            const int col0 = u.pn * BM + wc * 32 + 8 * fq;
#pragma unroll
            for (int ai = 0; ai < 2; ++ai)
#pragma unroll
                for (int m = 0; m < 4; ++m) { bf16_t* rowp = P + (size_t)(row0 + ai * HALF + m * 16) * PITCH_P + col0;
#pragma unroll
                    for (int bj = 0; bj < 2; ++bj) *(u32x4*)(rowp + bj * HALF) = pack8(acc[ai][bj][m][0], acc[ai][bj][m][1]); }
            return;
        }
        const int head = 4 * u.pn + wc;
        const bool lat = u.pm >= 16;
        if (head < 10) {
            const float* gsrc = head < 8 ? qn : kn;
            const float oscale = head < 8 ? QSCALE : 1.0f;
            f32x4 g[2][2];
#pragma unroll
            for (int bj = 0; bj < 2; ++bj)
#pragma unroll
                for (int n = 0; n < 2; ++n) g[bj][n] = *(const f32x4*)(gsrc + 32 * bj + 8 * fq + 4 * n);
            const float sgn = (fq & 2) ? 1.0f : -1.0f;
#pragma unroll
            for (int ai = 0; ai < 2; ++ai)
#pragma unroll
                for (int m = 0; m < 4; ++m) {
                    const int r = row0 + ai * HALF + m * 16;
                    float ss = 0.f;
#pragma unroll
                    for (int bj = 0; bj < 2; ++bj)
#pragma unroll
                        for (int n = 0; n < 2; ++n) { const f32x4 x = acc[ai][bj][m][n]; ss += (x[0] * x[0] + x[1] * x[1]) + (x[2] * x[2] + x[3] * x[3]); }
                    ss += __shfl_xor(ss, 16); ss += __shfl_xor(ss, 32);
                    const float rinv = 1.0f / sqrtf(ss * (1.0f / 64.0f) + RMS_EPS_F);
                    f32x4 v[2][2];
#pragma unroll
                    for (int bj = 0; bj < 2; ++bj)
#pragma unroll
                        for (int n = 0; n < 2; ++n) v[bj][n] = acc[ai][bj][m][n] * rinv * g[bj][n];
                    if (!lat && head >= 8) {
                        float* nk = newk + ((size_t)r * 2 + (head - 8)) * 64 + 8 * fq;
#pragma unroll
                        for (int bj = 0; bj < 2; ++bj)
#pragma unroll
                            for (int n = 0; n < 2; ++n) __builtin_nontemporal_store(v[bj][n], (f32x4*)(nk + 32 * bj + 4 * n));
                    }
                    if (lat) {
                        const int s = (r - TOK_CTX) & 1023;
#pragma unroll
                        for (int bj = 0; bj < 2; ++bj) {
                            const int pos = bj == 0 ? (s >> 6) : (s & 63);
#pragma unroll
                            for (int n = 0; n < 2; ++n) {
                                const f32x4 cs = *(const f32x4*)(rope + pos * 16 + 8 * (fq & 1) + 4 * n);
                                const f32x4 sn = *(const f32x4*)(rope + 1024 + pos * 16 + 8 * (fq & 1) + 4 * n);
                                f32x4 pt;
#pragma unroll
                                for (int j = 0; j < 4; ++j) pt[j] = __shfl_xor(v[bj][n][j], 32);
                                v[bj][n] = v[bj][n] * cs + pt * (sn * sgn);
                            }
                        }
                    }
                    bf16_t* dst;
                    if (head < 8) dst = P + (size_t)r * PITCH_P + head * 64 + 8 * fq;
                    else if (lat) { const int b = (r - TOK_CTX) >> 10, s = (r - TOK_CTX) & 1023; dst = Kl + ((size_t)(b * 2 + (head - 8)) * 1280 + 256 + s) * 64 + 8 * fq; }
                    else { const int b = r >> 8, s = r & 255; dst = Kc + ((size_t)(b * 2 + (head - 8)) * 256 + s) * 64 + 8 * fq; }
#pragma unroll
                    for (int bj = 0; bj < 2; ++bj) *(u32x4*)(dst + 32 * bj) = pack8(v[bj][0] * oscale, v[bj][1] * oscale);
                }
        } else {
            const int kvh = head - 10;
#pragma unroll
            for (int ai = 0; ai < 2; ++ai)
#pragma unroll
                for (int m = 0; m < 4; ++m) {
                    const int r = row0 + ai * HALF + m * 16;
                    bf16_t* vt; int T;
                    if (lat) { const int b = (r - TOK_CTX) >> 10, s = (r - TOK_CTX) & 1023; T = 1280; vt = Vl + (size_t)(b * 2 + kvh) * 64 * 1280 + 256 + s; }
                    else { const int b = r >> 8, s = r & 255; T = 256; vt = Vc + (size_t)(b * 2 + kvh) * 64 * 256 + s;
                        float* nv = newv + ((size_t)r * 2 + kvh) * 64 + 8 * fq;
#pragma unroll
                        for (int bj = 0; bj < 2; ++bj)
#pragma unroll
                            for (int n = 0; n < 2; ++n) __builtin_nontemporal_store(acc[ai][bj][m][n], (f32x4*)(nv + 32 * bj + 4 * n)); }
#pragma unroll
                    for (int bj = 0; bj < 2; ++bj)
#pragma unroll
                        for (int n = 0; n < 2; ++n)
#pragma unroll
                            for (int j = 0; j < 4; ++j) vt[(size_t)(32 * bj + 8 * fq + 4 * n + j) * T] = bf1(acc[ai][bj][m][n][j]);
                }
        }
    }
};

struct EpiRes {
    static constexpr bool PERM = false, AFTER_DRAIN = false; static constexpr int MT = 4;
    const float* xa; const float* xb; float* out; const float* gate;
    __device__ __forceinline__ void operator()(const f32x4 (&acc)[2][2][4][2], const Unit& u, int wr, int wc, int fr, int fq) const {
        const int row0 = u.pm * BM + wr * 64 + fr, col0 = u.pn * BM + wc * 32 + 4 * fq;
        const int mrow = u.pm < 16 ? 8 : ((u.pm - 16) >> 2);
        f32x4 g[2][2];
#pragma unroll
        for (int bj = 0; bj < 2; ++bj)
#pragma unroll
            for (int n = 0; n < 2; ++n) g[bj][n] = *(const f32x4*)(gate + (size_t)mrow * 6144 + col0 + bj * HALF + n * 16);
#pragma unroll
        for (int ai = 0; ai < 2; ++ai)
#pragma unroll
            for (int m = 0; m < 4; ++m) {
                const int r = row0 + ai * HALF + m * 16;
                const float* bp = (r < TOK_CTX ? xa + (size_t)r * 1024 : xb + (size_t)(r - TOK_CTX) * 1024) + col0;
                float* op = out + (size_t)r * 1024 + col0;
#pragma unroll
                for (int bj = 0; bj < 2; ++bj)
#pragma unroll
                    for (int n = 0; n < 2; ++n) { const f32x4 b = *(const f32x4*)(bp + bj * HALF + n * 16); *(f32x4*)(op + bj * HALF + n * 16) = b + g[bj][n] * acc[ai][bj][m][n]; }
            }
    }
};

struct EpiSwiGLU {
    static constexpr bool PERM = true, AFTER_DRAIN = false; static constexpr int MT = 4;
    bf16_t* act; int ldc;
    __device__ __forceinline__ void operator()(const f32x4 (&acc)[2][2][4][2], const Unit& u, int wr, int wc, int fr, int fq) const {
        const int row0 = u.pm * BM + wr * 64 + fr, col0 = u.pn * HALF + wc * 32 + 8 * fq;
#pragma unroll
        for (int ai = 0; ai < 2; ++ai)
#pragma unroll
            for (int m = 0; m < 4; ++m) {
                f32x4 o[2];
#pragma unroll
                for (int n = 0; n < 2; ++n) {
                    const f32x4 gt = acc[ai][0][m][n], up = acc[ai][1][m][n];
#pragma unroll
                    for (int j = 0; j < 4; ++j) { const float e = __builtin_amdgcn_exp2f(gt[j] * -1.4426950408889634f); o[n][j] = gt[j] * __builtin_amdgcn_rcpf(1.0f + e) * up[j]; }
                }
                *(u32x4*)(act + (size_t)(row0 + ai * HALF + m * 16) * ldc + col0) = pack8(o[0], o[1]);
            }
    }
};

struct EpiRes3 {
    static constexpr bool PERM = false, AFTER_DRAIN = false; static constexpr int MT = 3;
    const float* xa; const float* xb; float* out; const float* gate; bool nt_out;
    __device__ __forceinline__ void operator()(const f32x4 (&acc)[2][2][3][2], const Unit& u, int wr, int wc, int fr, int fq) const {
        const int col0 = u.pn * BM + wc * 32 + 4 * fq;
#pragma unroll
        for (int ai = 0; ai < 2; ++ai)
#pragma unroll
            for (int m = 0; m < 3; ++m) {
                const int rg = u.pm * 192 + ai * 96 + wr * 48 + m * 16, r = rg + fr;
                const int mrow = rg < TOK_CTX ? 8 : ((rg - TOK_CTX) >> 10);
                const float* gp = gate + (size_t)mrow * 6144 + col0;
                const float* bp = (r < TOK_CTX ? xa + (size_t)r * 1024 : xb + (size_t)(r - TOK_CTX) * 1024) + col0;
                float* op = out + (size_t)r * 1024 + col0;
#pragma unroll
                for (int bj = 0; bj < 2; ++bj)
#pragma unroll
                    for (int n = 0; n < 2; ++n) { const f32x4 b = __builtin_nontemporal_load((const f32x4*)(bp + bj * HALF + n * 16))  , g = *(const f32x4*)(gp + bj * HALF + n * 16); const f32x4 y = b + g * acc[ai][bj][m][n];
                        if (nt_out) __builtin_nontemporal_store(y, (f32x4*)(op + bj * HALF + n * 16)); else *(f32x4*)(op + bj * HALF + n * 16) = y; }
            }
    }
};
struct EpiSwiGLU3 {
    static constexpr bool PERM = true, AFTER_DRAIN = false; static constexpr int MT = 3;
    bf16_t* act; int ldc;
    __device__ __forceinline__ void operator()(const f32x4 (&acc)[2][2][3][2], const Unit& u, int wr, int wc, int fr, int fq) const {
        const int col0 = u.pn * HALF + wc * 32 + 8 * fq;
#pragma unroll
        for (int ai = 0; ai < 2; ++ai)
#pragma unroll
            for (int m = 0; m < 3; ++m) {
                const int r = u.pm * 192 + ai * 96 + wr * 48 + m * 16 + fr;
                f32x4 o[2];
#pragma unroll
                for (int n = 0; n < 2; ++n) {
                    const f32x4 gt = acc[ai][0][m][n], up = acc[ai][1][m][n];
#pragma unroll
                    for (int j = 0; j < 4; ++j) { const float e = __builtin_amdgcn_exp2f(gt[j] * -1.4426950408889634f); o[n][j] = gt[j] * __builtin_amdgcn_rcpf(1.0f + e) * up[j]; }
                }
                *(u32x4*)(act + (size_t)r * ldc + col0) = pack8(o[0], o[1]);
            }
    }
};
}
#define GAS __attribute__((address_space(1)))
#define LAS __attribute__((address_space(3)))
typedef unsigned short bf16;
typedef unsigned v4u __attribute__((ext_vector_type(4)));
typedef float f32x4 __attribute__((ext_vector_type(4)));
typedef float f32x16 __attribute__((ext_vector_type(16)));
typedef short bf16x8 __attribute__((ext_vector_type(8)));
constexpr int NWAVES = 8, NTHREADS = 512;
constexpr int D = 1024, M_CTX = 4096, M_ALL = 12288, IN_DIM = 2304, D_FF = 2816, NGU = 5632, MODW = 6144;
constexpr size_t MiB = 1u << 20;
constexpr size_t WS_MOD = 1 * MiB, WS_ROPE = 1 * MiB + 512 * 1024, WS_WIN = 2 * MiB, WS_WOUT = 7 * MiB, WS_WGU = 9 * MiB, WS_WDN = 20 * MiB;
constexpr size_t WS_KL = 26 * MiB, WS_VL = 29 * MiB, WS_KC = 32 * MiB, WS_VC = 33 * MiB, WS_H = 34 * MiB, WS_P = 58 * MiB, WS_MRG = 34 * MiB  , WS_ACT = 58 * MiB  , WS_END = 124 * MiB;
constexpr int RING_BYTES = 131072, LDS_BYTES = 147456;

__device__ __forceinline__ unsigned f2bf(float f) { unsigned u = __builtin_bit_cast(unsigned, f); return (u + 0x7fffu + ((u >> 16) & 1u)) >> 16; }
__device__ __forceinline__ unsigned pk2(float lo, float hi) { return f2bf(lo) | (f2bf(hi) << 16); }
__device__ __forceinline__ float bf2f(unsigned short h) { return __builtin_bit_cast(float, (unsigned)h << 16); }
__device__ __forceinline__ float wave_sum(float v) {
#pragma unroll
    for (int o = 1; o < 64; o <<= 1) v += __shfl_xor(v, o);
    return v;
}
#define LDS_WAIT() asm volatile("s_waitcnt lgkmcnt(0)" ::: "memory")

struct Args {
    const float* xp; const float* xs; const float* c; const float* cache_k; const float* cache_v; const float* c_ctx; const float* norm_mix; const float* norm_ffn;
    const float* w_ada; const float* b_ada; const float* w_in; const float* q_norm; const float* k_norm; const float* conv_w; const float* aon; const float* con;
    const float* w_out; const float* w_gu; const float* w_dn; float* out; unsigned char* ws; int ph_lo, ph_hi, li, pad;
};

__device__ __forceinline__ void transpose_item(const float* W, int ldw, int src0, int K, int k0, bf16* WT, int dst0, const float* kgain, LAS float* scr, int lane) {
#pragma unroll
    for (int i = 0; i < 32; ++i) { const int kk = 2 * i + (lane >> 5); float w = W[(size_t)(k0 + kk) * ldw + src0 + (lane & 31)]; if (kgain) w *= kgain[k0 + kk]; scr[kk * 33 + (lane & 31)] = w; }
    LDS_WAIT(); asm volatile("" ::: "memory");
    const int c = lane & 7;
#pragma unroll
    for (int j = 0; j < 4; ++j) { const int n = (lane >> 3) + 8 * j; const LAS float* s = scr + (8 * c) * 33 + n;
        v4u o; o.x = pk2(s[0 * 33], s[1 * 33]); o.y = pk2(s[2 * 33], s[3 * 33]); o.z = pk2(s[4 * 33], s[5 * 33]); o.w = pk2(s[6 * 33], s[7 * 33]);
        *(v4u*)(WT + (size_t)(dst0 + n) * K + k0 + 8 * c) = o; }
    LDS_WAIT(); asm volatile("" ::: "memory");
}

struct TrItem { const float* W; int ldw, src0, K, k0; bf16* WT; int dst0; const float* gain; };
__device__ __forceinline__ void tr_load(const TrItem& t, float (&w)[32], int lane) {
#pragma unroll
    for (int i = 0; i < 32; ++i) { const int kk = 2 * i + (lane >> 5); w[i] = __builtin_nontemporal_load(&t.W[(size_t)(t.k0 + kk) * t.ldw + t.src0 + (lane & 31)]); }
}
__device__ __forceinline__ void tr_store(const TrItem& t, const float (&w)[32], LAS float* scr, int lane) {
#pragma unroll
    for (int i = 0; i < 32; ++i) { const int kk = 2 * i + (lane >> 5); scr[kk * 33 + (lane & 31)] = t.gain ? w[i] * t.gain[t.k0 + kk] : w[i]; }
    LDS_WAIT(); asm volatile("" ::: "memory");
    const int c = lane & 7;
#pragma unroll
    for (int j = 0; j < 4; ++j) { const int n = (lane >> 3) + 8 * j; const LAS float* s = scr + (8 * c) * 33 + n;
        v4u o; o.x = pk2(s[0 * 33], s[1 * 33]); o.y = pk2(s[2 * 33], s[3 * 33]); o.z = pk2(s[4 * 33], s[5 * 33]); o.w = pk2(s[6 * 33], s[7 * 33]);
        *(v4u*)(t.WT + (size_t)(t.dst0 + n) * t.K + t.k0 + 8 * c) = o; }
    LDS_WAIT(); asm volatile("" ::: "memory");
}

template <bool NT> __device__ __forceinline__ void norm_rows2(const float* x0, const float* x1, const float* nw, const float* sc0, const float* sh0, const float* sc1, const float* sh1, bf16* o0, bf16* o1, int lane) {
    const f32x4* xr0 = (const f32x4*)x0 + lane; const f32x4* xr1 = (const f32x4*)x1 + lane;
    f32x4 v0[4], v1[4]; float s0 = 0.f, s1 = 0.f;
#pragma unroll
    for (int j = 0; j < 4; ++j) { if (NT) { v0[j] = __builtin_nontemporal_load(xr0 + 64 * j); v1[j] = __builtin_nontemporal_load(xr1 + 64 * j); } else { v0[j] = xr0[64 * j]; v1[j] = xr1[64 * j]; } }
#pragma unroll
    for (int j = 0; j < 4; ++j) { s0 += (v0[j].x * v0[j].x + v0[j].y * v0[j].y) + (v0[j].z * v0[j].z + v0[j].w * v0[j].w); s1 += (v1[j].x * v1[j].x + v1[j].y * v1[j].y) + (v1[j].z * v1[j].z + v1[j].w * v1[j].w); }
#pragma unroll
    for (int o = 1; o < 64; o <<= 1) { s0 += __shfl_xor(s0, o); s1 += __shfl_xor(s1, o); }
    const float r0 = 1.0f / sqrtf(s0 * (1.0f / 1024.0f) + 1e-6f), r1 = 1.0f / sqrtf(s1 * (1.0f / 1024.0f) + 1e-6f);
    unsigned long long* p0 = (unsigned long long*)o0 + lane; unsigned long long* p1 = (unsigned long long*)o1 + lane;
#pragma unroll
    for (int j = 0; j < 4; ++j) {
        const f32x4 w = ((const f32x4*)nw)[lane + 64 * j];
        const f32x4 a0 = ((const f32x4*)sc0)[lane + 64 * j], b0 = ((const f32x4*)sh0)[lane + 64 * j], a1 = ((const f32x4*)sc1)[lane + 64 * j], b1 = ((const f32x4*)sh1)[lane + 64 * j];
        const f32x4 y0 = v0[j] * r0 * w * (a0 + 1.0f) + b0, y1 = v1[j] * r1 * w * (a1 + 1.0f) + b1;
        p0[64 * j] = (unsigned long long)pk2(y0.x, y0.y) | ((unsigned long long)pk2(y0.z, y0.w) << 32);
        p1[64 * j] = (unsigned long long)pk2(y1.x, y1.y) | ((unsigned long long)pk2(y1.z, y1.w) << 32);
    }
}

constexpr int KVP = 144, KT_BYTES = 2 * 64 * KVP, BUF_BYTES = 2 * KT_BYTES;
constexpr int ATT_SC = 2 * BUF_BYTES, ATT_XS = ATT_SC + 8 * 64 * 4, OSP = 68;
__device__ __forceinline__ int crow(int r, int hi) { return (r & 3) + 8 * (r >> 2) + 4 * hi; }
__device__ __forceinline__ unsigned cvtpk(float lo, float hi) { return pg8::cvt_pk_bf16(lo, hi); }

#define ATT_THR 6.0f
__device__ __forceinline__ float max3f(float a, float b, float c) { float r; asm("v_max3_f32 %0, %1, %2, %3" : "=v"(r) : "v"(a), "v"(b), "v"(c)); return r; }
__device__ __forceinline__ float rowmax32(const f32x16& a, const f32x16& b) {
    float t[16];
#pragma unroll
    for (int r = 0; r < 16; ++r) t[r] = fmaxf(a[r], b[r]);
    float m0 = max3f(t[0], t[1], t[2]), m1 = max3f(t[3], t[4], t[5]);
    m0 = max3f(m0, t[6], t[7]); m1 = max3f(m1, t[8], t[9]); m0 = max3f(m0, t[10], t[11]); m1 = max3f(m1, t[12], t[13]); m0 = max3f(m0, t[14], t[15]);
    return fmaxf(m0, m1);
}
constexpr int ATT_SLOT = 16384, ATT_KR = 0, ATT_VR = 3 * ATT_SLOT, ATT_SC2 = 6 * ATT_SLOT, ATT_XS2 = ATT_SC2 + 8 * 64 * 4;
__device__ __forceinline__ void attn_unit(LAS unsigned char* lds, const bf16* Pq, int m0, const bf16* Kb, const bf16* Vb, int T, bf16* mrg) {
    const int tid = threadIdx.x, lane = tid & 63, r32 = lane & 31, hi = lane >> 5, wid = __builtin_amdgcn_readfirstlane(tid >> 6), kvh = wid >> 2;
    bf16x8 qr[4];
    { const bf16* qp = Pq + (size_t)(m0 + r32) * IN_DIM + wid * 64 + hi * 8;
#pragma unroll
      for (int d0 = 0; d0 < 4; ++d0) qr[d0] = *(const bf16x8*)(qp + d0 * 16); }
    const bf16* ksrc[2]; const bf16* vsrc[2];
#pragma unroll
    for (int i = 0; i < 2; ++i) { const int j = wid + 8 * i, kh = j >> 3, row = 8 * (j & 7) + (lane >> 3), c = (lane & 7) ^ ((row >> 1) & 7);
        ksrc[i] = Kb + ((size_t)(kh * T + row)) * 64 + c * 8; vsrc[i] = Vb + ((size_t)(kh * 64 + row)) * T + c * 8; }
    const int NT = T >> 6;
#define DMA_K(tk, sk) do { _Pragma("unroll") for (int i = 0; i < 2; ++i) \
        __builtin_amdgcn_global_load_lds((const unsigned*)(ksrc[i] + (size_t)(tk) * 64 * 64), (LAS unsigned*)(lds + ATT_KR + (sk) * ATT_SLOT + (wid + 8 * i) * 1024), 16, 0, 0); } while (0)
#define DMA_V(tv, sv) do { _Pragma("unroll") for (int i = 0; i < 2; ++i) \
        __builtin_amdgcn_global_load_lds((const unsigned*)(vsrc[i] + (tv) * 64), (LAS unsigned*)(lds + ATT_VR + (sv) * ATT_SLOT + (wid + 8 * i) * 1024), 16, 0, 0); } while (0)
#define DMA_KV(tk, sk, tv, sv) do { DMA_K(tk, sk); DMA_V(tv, sv); } while (0)
    DMA_KV(0, 0, 0, 0); DMA_KV(1, 1, 0, 0); DMA_KV(2, 2, 1, 1);
    const int pr = (r32 & ~12) | ((r32 & 4) << 1) | ((r32 & 8) >> 1);
    int koffs[4], voffs[4];
#pragma unroll
    for (int d0 = 0; d0 < 4; ++d0) { koffs[d0] = kvh * 8192 + pr * 128 + (((2 * d0 + hi) ^ ((pr >> 1) & 7)) << 4); voffs[d0] = kvh * 8192 + r32 * 128 + (((2 * d0 + hi) ^ ((r32 >> 1) & 7)) << 4); }
    LAS float* sc = (LAS float*)(lds + ATT_SC2) + wid * 64;
    const unsigned ldsb = (unsigned)(uintptr_t)lds;
#define DSR(dst, addr, off) asm volatile("ds_read_b128 %0, %1 offset:%2" : "=v"(dst) : "v"(addr), "i"(off) : "memory")
    asm volatile("s_waitcnt vmcnt(4)" ::: "memory"); __builtin_amdgcn_s_barrier(); asm volatile("" ::: "memory");
    f32x16 o0 = {}, o1 = {}, o2 = {};
    const bf16x8 ones = {16256, 16256, 16256, 16256, 16256, 16256, 16256, 16256};
    f32x16 c0 = {}, c1 = {}, n0, n1;
#pragma unroll
    for (int d0 = 0; d0 < 4; ++d0) {
        const bf16x8 k0 = *(const LAS bf16x8*)(lds + ATT_KR + koffs[d0]), k1 = *(const LAS bf16x8*)(lds + ATT_KR + koffs[d0] + 32 * 128);
        c0 = __builtin_amdgcn_mfma_f32_32x32x16_bf16(k0, qr[d0], c0, 0, 0, 0);
        c1 = __builtin_amdgcn_mfma_f32_32x32x16_bf16(k1, qr[d0], c1, 0, 0, 0);
    }
    asm volatile("s_waitcnt lgkmcnt(0)" ::: "memory"); __builtin_amdgcn_s_barrier(); asm volatile("" ::: "memory");
    float mrun = rowmax32(c0, c1), rmc = 0.f; mrun = fmaxf(mrun, __shfl_xor(mrun, 32));
#pragma unroll
    for (int r = 0; r < 16; ++r) { c0[r] -= mrun; c1[r] -= mrun; }
    int sk1 = 1, sv0 = 0;
#define ATT_ITER(t, MORE, C0, C1, N0, N1) do { \
        const bool dk_ = (t) + 3 < NT, dv_ = (t) + 2 < NT;       \
        { const int skn_ = sk1 == 0 ? 2 : sk1 - 1, svn_ = sv0 == 0 ? 2 : sv0 - 1; if (dk_) DMA_K((t) + 3, skn_); if (dv_) DMA_V((t) + 2, svn_); } \
        if (__any(rmc > ATT_THR)) { \
            const float rmf_ = fmaxf(rmc, __shfl_xor(rmc, 32)); const float dl = fmaxf(rmf_, 0.f), alpha = __builtin_amdgcn_exp2f(-dl); mrun += dl; \
            _Pragma("unroll") for (int r = 0; r < 16; ++r) { C0[r] -= dl; C1[r] -= dl; } \
            if (hi == 0) sc[r32] = alpha; \
            _Pragma("unroll") for (int g = 0; g < 4; ++g) { const f32x4 a4 = *(const LAS f32x4*)(sc + 8 * g + 4 * hi); \
                _Pragma("unroll") for (int i = 0; i < 4; ++i) { o0[4 * g + i] *= a4[i]; o1[4 * g + i] *= a4[i]; o2[4 * g + i] *= a4[i]; } } \
        } \
        bf16x8 kf_[8], vf_[8]; \
        { const unsigned kb_ = ldsb + ATT_KR + sk1 * ATT_SLOT, vb_ = ldsb + ATT_VR + sv0 * ATT_SLOT; \
          if (MORE) { _Pragma("unroll") for (int d0 = 0; d0 < 4; ++d0) { DSR(kf_[2 * d0], kb_ + koffs[d0], 0); DSR(kf_[2 * d0 + 1], kb_ + koffs[d0], 4096); } } \
          _Pragma("unroll") for (int s4 = 0; s4 < 2; ++s4) { DSR(vf_[2 * s4], vb_ + voffs[s4], 0); DSR(vf_[2 * s4 + 1], vb_ + voffs[s4], 4096); } \
          asm volatile("s_waitcnt lgkmcnt(4)" ::: "memory"); __builtin_amdgcn_sched_barrier(0);        \
          _Pragma("unroll") for (int s4 = 2; s4 < 4; ++s4) { DSR(vf_[2 * s4], vb_ + voffs[s4], 0); DSR(vf_[2 * s4 + 1], vb_ + voffs[s4], 4096); } } \
        if (MORE) { f32x16 negm; _Pragma("unroll") for (int r = 0; r < 16; ++r) negm[r] = -mrun; \
              _Pragma("unroll") for (int d0 = 0; d0 < 4; ++d0) { \
              N0 = __builtin_amdgcn_mfma_f32_32x32x16_bf16(kf_[2 * d0], qr[d0], d0 == 0 ? negm : N0, 0, 0, 0); \
              N1 = __builtin_amdgcn_mfma_f32_32x32x16_bf16(kf_[2 * d0 + 1], qr[d0], d0 == 0 ? negm : N1, 0, 0, 0); } } \
        _Pragma("unroll") for (int r = 0; r < 16; ++r) { C0[r] = __builtin_amdgcn_exp2f(C0[r]); C1[r] = __builtin_amdgcn_exp2f(C1[r]); } \
        v4u pw[4]; \
        _Pragma("unroll") for (int s2 = 0; s2 < 2; ++s2) { \
            pw[s2]     = (v4u){cvtpk(C0[8 * s2], C0[8 * s2 + 1]), cvtpk(C0[8 * s2 + 2], C0[8 * s2 + 3]), cvtpk(C0[8 * s2 + 4], C0[8 * s2 + 5]), cvtpk(C0[8 * s2 + 6], C0[8 * s2 + 7])}; \
            pw[2 + s2] = (v4u){cvtpk(C1[8 * s2], C1[8 * s2 + 1]), cvtpk(C1[8 * s2 + 2], C1[8 * s2 + 3]), cvtpk(C1[8 * s2 + 4], C1[8 * s2 + 5]), cvtpk(C1[8 * s2 + 6], C1[8 * s2 + 7])}; } \
        asm volatile("s_waitcnt lgkmcnt(0)" ::: "memory"); __builtin_amdgcn_sched_barrier(0); \
        _Pragma("unroll") for (int s4 = 0; s4 < 4; ++s4) { \
            o0 = __builtin_amdgcn_mfma_f32_32x32x16_bf16(__builtin_bit_cast(bf16x8, pw[s4]), vf_[2 * s4], o0, 0, 0, 0); \
            o1 = __builtin_amdgcn_mfma_f32_32x32x16_bf16(__builtin_bit_cast(bf16x8, pw[s4]), vf_[2 * s4 + 1], o1, 0, 0, 0); \
            o2 = __builtin_amdgcn_mfma_f32_32x32x16_bf16(__builtin_bit_cast(bf16x8, pw[s4]), ones, o2, 0, 0, 0); } \
        rmc = MORE ? rowmax32(N0, N1) : 0.f; \
        sk1 = sk1 == 2 ? 0 : sk1 + 1; sv0 = sv0 == 2 ? 0 : sv0 + 1; \
        if (dk_) asm volatile("s_waitcnt vmcnt(4)" ::: "memory"); else if (dv_) asm volatile("s_waitcnt vmcnt(2)" ::: "memory"); else asm volatile("s_waitcnt vmcnt(0)" ::: "memory");     \
        asm volatile("s_waitcnt lgkmcnt(0)" ::: "memory"); __builtin_amdgcn_s_barrier(); asm volatile("" ::: "memory"); \
    } while (0)
    int t = 0;
    for (; t < NT - 2; t += 2) {
        ATT_ITER(t, true, c0, c1, n0, n1);
        ATT_ITER(t + 1, true, n0, n1, c0, c1);
    }
    ATT_ITER(t, true, c0, c1, n0, n1);
    ATT_ITER(t + 1, false, n0, n1, c0, c1);
#undef ATT_ITER
#undef DMA_KV
#undef DMA_K
#undef DMA_V
#undef DSR
    asm volatile("s_waitcnt vmcnt(0)" ::: "memory"); __builtin_amdgcn_s_barrier(); asm volatile("" ::: "memory");
    LAS float* st = (LAS float*)lds + wid * (32 * OSP);
#pragma unroll
    for (int r = 0; r < 16; ++r) { const float rl = 1.0f / o2[r]; st[crow(r, hi) * OSP + r32] = o0[r] * rl; st[crow(r, hi) * OSP + 32 + r32] = o1[r] * rl; }
    const int q = lane >> 1, hf = lane & 1;
    f32x4 ov[8]; float ss = 0.f;
#pragma unroll
    for (int i = 0; i < 8; ++i) { ov[i] = *(const LAS f32x4*)(st + q * OSP + 32 * hf + 4 * i); ss += (ov[i].x * ov[i].x + ov[i].y * ov[i].y) + (ov[i].z * ov[i].z + ov[i].w * ov[i].w); }
    ss += __shfl_xor(ss, 1);
    LAS float* xs = (LAS float*)(lds + ATT_XS2);
    if (hf == 0) xs[wid * 32 + q] = ss;
    __syncthreads();
    float tot = 0.f;
#pragma unroll
    for (int w = 0; w < 8; ++w) tot += xs[w * 32 + q];
    const float rinv = 1.0f / sqrtf(tot * (1.0f / 512.0f) + 1e-6f);
    bf16* op = mrg + (size_t)(m0 + q) * D + wid * 64 + 32 * hf;
#pragma unroll
    for (int i = 0; i < 4; ++i) { const f32x4 a = ov[2 * i] * rinv, b = ov[2 * i + 1] * rinv; v4u w; w.x = pk2(a.x, a.y); w.y = pk2(a.z, a.w); w.z = pk2(b.x, b.y); w.w = pk2(b.z, b.w); *(v4u*)(op + 8 * i) = w; }
    __syncthreads();
}

__device__ __forceinline__ void unpack8(const v4u v, float (&f)[8]) {
#pragma unroll
    for (int i = 0; i < 4; ++i) { f[2 * i] = __builtin_bit_cast(float, v[i] << 16); f[2 * i + 1] = __builtin_bit_cast(float, v[i] & 0xffff0000u); }
}
__device__ __forceinline__ void conv_run6(const bf16* P, const float* cw, int m0, bf16* mrg, int lane) {
    v4u gcr[8], ur[8], gbr[6];
#pragma unroll
    for (int i = 0; i < 8; ++i) { int m = m0 - 1 + i; m = m < 0 ? 0 : (m > M_ALL - 1 ? M_ALL - 1 : m); const bf16* row = P + (size_t)m * IN_DIM + 8 * lane; gcr[i] = *(const v4u*)(row + 1280); ur[i] = *(const v4u*)(row + 1792); }
#pragma unroll
    for (int i = 0; i < 6; ++i) gbr[i] = *(const v4u*)(P + (size_t)(m0 + i) * IN_DIM + 8 * lane + 768);
    float w0[8], w1[8], w2[8];
#pragma unroll
    for (int i = 0; i < 8; ++i) { w0[i] = cw[8 * lane + i]; w1[i] = cw[512 + 8 * lane + i]; w2[i] = cw[1024 + 8 * lane + i]; }
    float z[8][8];
#pragma unroll
    for (int i = 0; i < 8; ++i) { float a[8], b[8]; unpack8(gcr[i], a); unpack8(ur[i], b);
#pragma unroll
        for (int c = 0; c < 8; ++c) z[i][c] = a[c] * b[c]; }
#pragma unroll
    for (int t = 0; t < 6; ++t) {
        const int m = m0 + t; const int s = m < M_CTX ? (m & 255) : ((m - M_CTX) & 1023), L = m < M_CTX ? 256 : 1024;
        const float fp = s > 0 ? 1.0f : 0.0f, fn = s < L - 1 ? 1.0f : 0.0f;
        float g[8], y[8]; unpack8(gbr[t], g); float ss = 0.f;
#pragma unroll
        for (int c = 0; c < 8; ++c) { y[c] = g[c] * (w0[c] * fp * z[t][c] + w1[c] * z[t + 1][c] + w2[c] * fn * z[t + 2][c]); ss += y[c] * y[c]; }
        const float rinv = 1.0f / sqrtf(wave_sum(ss) * (1.0f / 512.0f) + 1e-6f);
        v4u o; o.x = pk2(y[0] * rinv, y[1] * rinv); o.y = pk2(y[2] * rinv, y[3] * rinv); o.z = pk2(y[4] * rinv, y[5] * rinv); o.w = pk2(y[6] * rinv, y[7] * rinv);
        *(v4u*)(mrg + (size_t)m * D + 512 + 8 * lane) = o;
    }
}

#define XB_TMO      128
#define XB_XCNT(j)  (256  + 64 * (j))
#define XB_XSUB(j)  (1280 + 64 * (j))
#define XB_XGEN(j)  (2304 + 64 * (j))
#define XB_TOP      3328
#define XB_TOPGEN   3392
#define XCD_BAR_WORDS 3456
#define XB_SPIN_CAP (1u << 18)

__device__ __forceinline__ unsigned xb_ld(unsigned* p)              { return __hip_atomic_load(p, __ATOMIC_RELAXED, __HIP_MEMORY_SCOPE_AGENT); }
__device__ __forceinline__ unsigned xb_add(unsigned* p, unsigned v) { return __hip_atomic_fetch_add(p, v, __ATOMIC_RELAXED, __HIP_MEMORY_SCOPE_AGENT); }
__device__ __forceinline__ unsigned xb_xcc_id() { return (unsigned)__builtin_amdgcn_s_getreg((3 << 11) | 20) & 0xFu; }
#define XB_SPIN(cond, bar) do { unsigned _sp = 0; while (cond) { __builtin_amdgcn_s_sleep(1); \
    if ((++_sp & 255u) == 0u) { if (xb_ld(&(bar)[XB_TMO])) break; if (_sp > XB_SPIN_CAP) { atomicAdd(&(bar)[XB_TMO], 1u); break; } } } } while (0)

struct XcdBarrier {
    unsigned* bar; unsigned x;
    volatile LAS unsigned* st;
};

__device__ __forceinline__ XcdBarrier xcd_barrier_post(unsigned* bar, volatile LAS unsigned* st) {
    XcdBarrier b; b.bar = bar; b.x = xb_xcc_id(); b.st = st;
    if (threadIdx.x == 0) (void)xb_add(&bar[XB_XCNT(b.x)], 1u);
    return b;
}
__device__ __forceinline__ void xcd_barrier_complete(unsigned* bar, unsigned x, unsigned& nloc, unsigned& nx) {
    const unsigned G = gridDim.x * gridDim.y * gridDim.z;
    unsigned sum, cnt, mine, sp = 0u;
    for (;;) {
        sum = 0u; cnt = 0u; mine = 0u;
#pragma unroll
        for (unsigned j = 0; j < 16; ++j) { const unsigned c = xb_ld(&bar[XB_XCNT(j)]); sum += c; cnt += (c > 0u) ? 1u : 0u; mine = (j == x) ? c : mine; }
        if (sum == G) break;
        __builtin_amdgcn_s_sleep(1);
        if ((++sp & 255u) == 0u) { if (xb_ld(&bar[XB_TMO])) break; if (sp > XB_SPIN_CAP) { atomicAdd(&bar[XB_TMO], 1u); break; } }
    }
    nloc = mine > 0u ? mine : 1u; nx = cnt > 0u ? cnt : 1u;
}

__device__ __forceinline__ void xcd_barrier(const XcdBarrier& b) {
    asm volatile("s_waitcnt vmcnt(0)" ::: "memory");
    __syncthreads();
    if (threadIdx.x == 0) {
        unsigned* bar = b.bar;
        __builtin_amdgcn_s_waitcnt(0);
        unsigned nloc = b.st[0], nx = b.st[1];
        if (nloc == 0u) { xcd_barrier_complete(bar, b.x, nloc, nx); b.st[0] = nloc; b.st[1] = nx; }
        const unsigned old = xb_add(&bar[XB_XSUB(b.x)], 1u);
        const unsigned gen = old / nloc;
        if (old + 1u == (gen + 1u) * nloc) {
            __builtin_amdgcn_fence(__ATOMIC_RELEASE, "agent");
            asm volatile("s_waitcnt vmcnt(0)" ::: "memory");
            const unsigned og = xb_add(&bar[XB_TOP], 1u);
            const unsigned tg = og / nx;
            if (og + 1u == (tg + 1u) * nx) xb_add(&bar[XB_TOPGEN], 1u);
            else XB_SPIN(xb_ld(&bar[XB_TOPGEN]) == tg, bar);
            __builtin_amdgcn_fence(__ATOMIC_ACQUIRE, "agent");
            xb_add(&bar[XB_XGEN(b.x)], 1u);
            asm volatile("s_waitcnt vmcnt(0)" ::: "memory");
        } else {
            XB_SPIN(xb_ld(&bar[XB_XGEN(b.x)]) == gen, bar);
            __builtin_amdgcn_fence(__ATOMIC_ACQUIRE, "agent");
            asm volatile("s_waitcnt vmcnt(0)" ::: "memory");
        }
    }
    __syncthreads();
}

__global__ void __launch_bounds__(NTHREADS, 2) fwd_kernel(Args a) {
    extern __shared__ __attribute__((aligned(16))) unsigned char lds_raw[];
    LAS unsigned char* lds = (LAS unsigned char*)lds_raw;
    cg::grid_group grid = cg::this_grid();
    const int tid = threadIdx.x, lane = tid & 63, wave = __builtin_amdgcn_readfirstlane(tid >> 6);
    const int G = gridDim.x, bx = blockIdx.x;
    const int vcu = (G % 8 == 0) ? (bx % 8) * (G / 8) + bx / 8 : bx;
    unsigned char* ws = a.ws;
    float* mod = (float*)(ws + WS_MOD); float* rope = (float*)(ws + WS_ROPE);
    bf16* Win = (bf16*)(ws + WS_WIN); bf16* Wout = (bf16*)(ws + WS_WOUT); bf16* Wgu = (bf16*)(ws + WS_WGU); bf16* Wdn = (bf16*)(ws + WS_WDN);
    bf16* Kl = (bf16*)(ws + WS_KL); bf16* Vl = (bf16*)(ws + WS_VL); bf16* Kc = (bf16*)(ws + WS_KC); bf16* Vc = (bf16*)(ws + WS_VC);
    bf16* H = (bf16*)(ws + WS_H); bf16* P = (bf16*)(ws + WS_P); bf16* MRG = (bf16*)(ws + WS_MRG); bf16* ACT = (bf16*)(ws + WS_ACT); float* X1 = a.out;
    float* newk = a.out + (size_t)M_ALL * D; float* newv = newk + 16 * 256 * 128;
    const int lo = a.ph_lo, hi = a.ph_hi;
#define IN(k) (lo <= (k) && (k) < hi)
#define SEAM(k) do { if (IN(k) && IN((k) + 1)) xcd_barrier(bar); } while (0)
    volatile LAS unsigned* misc = (volatile LAS unsigned*)(lds + LDS_BYTES - 256);
    if (tid < 64) misc[tid] = 0u;
    __syncthreads();
    XcdBarrier bar = xcd_barrier_post((unsigned*)ws + a.li * XCD_BAR_WORDS, misc);
    if (a.ph_lo < 0) grid.sync();

    if (IN(0)) {
        if (bx < 96) {
            LAS float* sl = (LAS float*)lds;
            for (int i = tid; i < 9 * 1024; i += NTHREADS) { const float v = i < 8192 ? a.c[i] : a.c_ctx[i - 8192]; sl[i] = v / (1.0f + __expf(-v)); }
            __syncthreads();
            const int cgp = lane & 15, ks = lane >> 4;
            f32x4 acc[9];
#pragma unroll
            for (int r = 0; r < 9; ++r) acc[r] = (f32x4){0.f, 0.f, 0.f, 0.f};
            const float* wp = a.w_ada + (size_t)(128 * wave + ks) * MODW + 64 * bx + 4 * cgp;
#pragma unroll 1
            for (int i0 = 0; i0 < 32; i0 += 16) {
                f32x4 w[16];
#pragma unroll
                for (int j = 0; j < 16; ++j) w[j] = __builtin_nontemporal_load((const f32x4*)(wp + (size_t)(4 * (i0 + j)) * MODW));
#pragma unroll
                for (int j = 0; j < 16; ++j) { const int k = 128 * wave + 4 * (i0 + j) + ks;
#pragma unroll
                    for (int r = 0; r < 9; ++r) acc[r] += w[j] * sl[r * 1024 + k]; }
            }
            LAS float* red = (LAS float*)(lds + 40960);
#pragma unroll
            for (int r = 0; r < 9; ++r) {
#pragma unroll
                for (int j = 0; j < 4; ++j) { float v = acc[r][j]; v += __shfl_xor(v, 16); v += __shfl_xor(v, 32); acc[r][j] = v; }
                if (ks == 0) *(LAS f32x4*)(red + (wave * 9 + r) * 64 + 4 * cgp) = acc[r];
            }
            __syncthreads();
            for (int i = tid; i < 9 * 64; i += NTHREADS) { const int r = i >> 6, l = i & 63; float s = a.b_ada[64 * bx + l];
#pragma unroll
                for (int w = 0; w < 8; ++w) s += red[(w * 9 + r) * 64 + l];
                mod[r * MODW + 64 * bx + l] = s; }
            __syncthreads();
        }
        {
            LAS float* scr = (LAS float*)(lds + wave * 17408);
            const int gw = bx * NWAVES + wave, NGW = G * NWAVES;
            constexpr int I_IN = 16 * 72, I_OUT = 16 * 32, I_GU = 16 * 176, I_DN = 44 * 32;
            const bool bal = (G == 256);
            const int nhere = bal ? I_IN + I_OUT + I_DN : I_IN + I_OUT + I_DN + I_GU;
            const int nit = bal ? (bx < 96 ? 0 : ((bx - 96) * NWAVES + wave < 512 ? 3 : 2)) : (nhere - gw + NGW - 1) / NGW;
            auto decode = [&](int ii) -> TrItem {
                const int it = bal ? (bx - 96) * NWAVES + wave + 1280 * ii : gw + ii * NGW;
                int r = it; TrItem t;
                if (r < I_IN) { const int kb = r / 72, db = r % 72, pn = db >> 3, bj = (db >> 2) & 1, wc = db & 3; const int src = pn < 3 ? 64 * (4 * pn + wc) + 32 * bj : 32 * db;
                    t = TrItem{a.w_in, IN_DIM, src, D, 64 * kb, Win, 32 * db, nullptr}; return t; } r -= I_IN;
                if (r < I_OUT) { const int kb = r / 32, db = r % 32; t = TrItem{a.w_out, D, 32 * db, D, 64 * kb, Wout, 32 * db, kb < 8 ? a.aon : a.con - 512}; return t; } r -= I_OUT;
                if (r < I_DN) { const int kb = r / 32, db = r % 32; t = TrItem{a.w_dn, D, 32 * db, D_FF, 64 * kb, Wdn, 32 * db, nullptr}; return t; } r -= I_DN;
                { const int kb = r / 176, db = r % 176, pn = db >> 3, bj = (db >> 2) & 1, qq = db & 3; const int src = (bj ? D_FF : 0) + 128 * pn + 32 * qq;
                    t = TrItem{a.w_gu, NGU, src, D, 64 * kb, Wgu, 32 * db, nullptr}; return t; }
            };
            int ii = 0;
            if (nit == 3) {
                const TrItem t0 = decode(0), t1 = decode(1), t2 = decode(2);
                float w0[32], w1[32], w2[32];
                tr_load(t0, w0, lane); tr_load(t1, w1, lane); tr_load(t2, w2, lane);
                tr_store(t0, w0, scr, lane); tr_store(t1, w1, scr + 2176, lane); tr_store(t2, w2, scr, lane);
                ii = 3;
            }
            for (; ii + 1 < nit; ii += 2) {
                const TrItem t0 = decode(ii), t1 = decode(ii + 1);
                float w0[32], w1[32];
                tr_load(t0, w0, lane); tr_load(t1, w1, lane);
                tr_store(t0, w0, scr, lane); tr_store(t1, w1, scr + 2176, lane);
            }
            if (ii < nit) { const TrItem t0 = decode(ii); float w0[32]; tr_load(t0, w0, lane); tr_store(t0, w0, scr, lane); }
        }
        {
            const int gt = bx * NTHREADS + tid, NGT = G * NTHREADS;
            for (int i = gt; i < 8 * 256 * 128; i += NGT) { const int d = i & 63, kh = (i >> 6) & 1, key = (i >> 7) & 255, b = i >> 15;
                Kl[((size_t)(b * 2 + kh) * 1280 + key) * 64 + d] = (bf16)f2bf(__builtin_nontemporal_load(a.cache_k + i));
                Vl[((size_t)(b * 2 + kh) * 64 + d) * 1280 + key] = (bf16)f2bf(__builtin_nontemporal_load(a.cache_v + i)); }
            if (gt < 1024) { const int pos = gt >> 4, p = gt & 15; const float inv = 1.0f / powf(10000.0f, (float)p / 16.0f); const float ang = (float)pos * inv; rope[gt] = cosf(ang); rope[1024 + gt] = sinf(ang); }
        }
    }
    SEAM(0);
    if (IN(1)) {
        const int gw = vcu * NWAVES + wave, NGW = G * NWAVES;
        for (int m = gw; m < M_ALL; m += 2 * NGW) {
            const int m2 = m + NGW < M_ALL ? m + NGW : m;
            const float* xa = m < M_CTX ? a.xp + (size_t)m * D : a.xs + (size_t)(m - M_CTX) * D;
            const float* xb = m2 < M_CTX ? a.xp + (size_t)m2 * D : a.xs + (size_t)(m2 - M_CTX) * D;
            const float* ma = mod + (size_t)(m < M_CTX ? 8 : (m - M_CTX) >> 10) * MODW;
            const float* mb = mod + (size_t)(m2 < M_CTX ? 8 : (m2 - M_CTX) >> 10) * MODW;
            norm_rows2<true>(xa, xb, a.norm_mix, ma + 1024, ma, mb + 1024, mb, H + (size_t)m * D, H + (size_t)m2 * D, lane);
        }
    }
    SEAM(1);
    if (IN(2)) {
        pg8::Gemm g{H, Win, M_ALL, IN_DIM, D}; pg8::StaticOrder S; S.init(M_ALL, IN_DIM, G, bx);
        pg8::EpiIn E{P, Kl, Vl, Kc, Vc, newk, newv, a.q_norm, a.k_norm, rope};
        pg8::gemm_phase<pg8::EpiIn, pg8::StaticOrder, true, true>(lds, g, S, E);
        if (G == 256 && bx >= 176) {
            LAS float* scr = (LAS float*)(lds + wave * 17408);
            constexpr int I_GU = 16 * 176;
            for (int it = (bx - 176) * NWAVES + wave; it < I_GU; it += 2 * 80 * NWAVES) {
                const int it2 = it + 80 * NWAVES;
                auto dec = [&](int r) -> TrItem { const int kb = r / 176, db = r % 176, pn = db >> 3, bj = (db >> 2) & 1, qq = db & 3; const int src = (bj ? D_FF : 0) + 128 * pn + 32 * qq; return TrItem{a.w_gu, NGU, src, D, 64 * kb, Wgu, 32 * db, nullptr}; };
                const TrItem t0 = dec(it); float w0[32]; tr_load(t0, w0, lane);
                if (it2 < I_GU) { const TrItem t1 = dec(it2); float w1[32]; tr_load(t1, w1, lane); tr_store(t0, w0, scr, lane); tr_store(t1, w1, scr + 2176, lane); }
                else tr_store(t0, w0, scr, lane);
            }
        }
    }
    SEAM(2);
    if (IN(3)) {
        for (int u = vcu; u < 384; u += G) {
            if (u < 256) { const int b = u >> 5, qb = u & 31; attn_unit(lds, P, M_CTX + b * 1024 + qb * 32, Kl + (size_t)b * 2 * 1280 * 64, Vl + (size_t)b * 2 * 64 * 1280, 1280, MRG); }
            else { const int b = (u - 256) >> 3, qb = (u - 256) & 7; attn_unit(lds, P, b * 256 + qb * 32, Kc + (size_t)b * 2 * 256 * 64, Vc + (size_t)b * 2 * 64 * 256, 256, MRG); }
        }
        const int gw = vcu * NWAVES + wave, NGW = G * NWAVES;
        if (G == 256) { if (vcu >= 128) { const int w2 = (vcu - 128) * NWAVES + wave; conv_run6(P, a.conv_w, 6 * w2, MRG, lane); conv_run6(P, a.conv_w, 6 * (w2 + 1024), MRG, lane); } }
        else for (int r = gw; r < M_ALL / 6; r += NGW) conv_run6(P, a.conv_w, 6 * r, MRG, lane);
    }
    SEAM(3);
    if (IN(4)) {
        pg8::Gemm g{MRG, Wout, M_ALL, D, D}; pg8::StaticOrder S; S.init(M_ALL, D, G, bx, 192);
        pg8::EpiRes3 E{a.xp, a.xs, X1, mod + 2048, false};
        pg8::gemm_phase<pg8::EpiRes3, pg8::StaticOrder, true, true>(lds, g, S, E);
    }
    SEAM(4);
    if (IN(5)) {
        const int gw = vcu * NWAVES + wave, NGW = G * NWAVES;
        for (int m = gw; m < M_ALL; m += 2 * NGW) {
            const int m2 = m + NGW < M_ALL ? m + NGW : m;
            const float* ma = mod + (size_t)(m < M_CTX ? 8 : (m - M_CTX) >> 10) * MODW;
            const float* mb = mod + (size_t)(m2 < M_CTX ? 8 : (m2 - M_CTX) >> 10) * MODW;
            norm_rows2<false>(X1 + (size_t)m * D, X1 + (size_t)m2 * D, a.norm_ffn, ma + 4096, ma + 3072, mb + 4096, mb + 3072, H + (size_t)m * D, H + (size_t)m2 * D, lane);
        }
    }
    SEAM(5);
    if (IN(6)) {
        pg8::Gemm g{H, Wgu, M_ALL, NGU, D}; pg8::StaticOrder S; S.init(M_ALL, NGU, G, bx, 192);
        pg8::EpiSwiGLU3 E{ACT, D_FF};
        pg8::gemm_phase<pg8::EpiSwiGLU3, pg8::StaticOrder, true, true>(lds, g, S, E);
    }
    SEAM(6);
    if (IN(7)) {
        pg8::Gemm g{ACT, Wdn, M_ALL, D, D_FF}; pg8::StaticOrder S; S.init(M_ALL, D, G, bx, 192);
        pg8::EpiRes3 E{X1, X1 + (size_t)M_CTX * D, a.out, mod + 5120, true};
        pg8::gemm_phase<pg8::EpiRes3, pg8::StaticOrder, true, true>(lds, g, S, E);
    }
#undef IN
#undef SEAM
}

#ifndef MK_N_LAUNCHES
#define MK_N_LAUNCHES 1
#endif
extern "C" void kernel_launch(void* const* d_in, const int* in_sizes, int n_in, void* d_out, int out_size, void* d_ws, size_t ws_size, hipStream_t stream) {
    static int grid = 0;
    if (grid == 0) {
        int dev = 0, cus = 0, per_cu = 0;
        hipGetDevice(&dev); hipDeviceGetAttribute(&cus, hipDeviceAttributeMultiprocessorCount, dev);
        if (hipFuncSetAttribute((const void*)fwd_kernel, hipFuncAttributeMaxDynamicSharedMemorySize, LDS_BYTES) != hipSuccess) { fprintf(stderr, "kernel_launch: hipFuncSetAttribute failed\n"); grid = -1; return; }
        hipOccupancyMaxActiveBlocksPerMultiprocessor(&per_cu, (const void*)fwd_kernel, NTHREADS, LDS_BYTES);
        (void)hipGetLastError();
        if (per_cu < 1) { fprintf(stderr, "kernel_launch: occupancy query says %d blocks per CU\n", per_cu); per_cu = 1; }
        grid = cus;
        if (n_in != 19 || ws_size < WS_END) { fprintf(stderr, "kernel_launch: unexpected n_in %d / ws %zu\n", n_in, ws_size); grid = -1; return; }
    }
    if (grid < 0) return;
    Args a{};
    a.xp = (const float*)d_in[0]; a.xs = (const float*)d_in[1]; a.c = (const float*)d_in[2]; a.cache_k = (const float*)d_in[3]; a.cache_v = (const float*)d_in[4]; a.c_ctx = (const float*)d_in[5];
    a.norm_mix = (const float*)d_in[6]; a.norm_ffn = (const float*)d_in[7]; a.w_ada = (const float*)d_in[8]; a.b_ada = (const float*)d_in[9]; a.w_in = (const float*)d_in[10];
    a.q_norm = (const float*)d_in[11]; a.k_norm = (const float*)d_in[12]; a.conv_w = (const float*)d_in[13]; a.aon = (const float*)d_in[14]; a.con = (const float*)d_in[15];
    a.w_out = (const float*)d_in[16]; a.w_gu = (const float*)d_in[17]; a.w_dn = (const float*)d_in[18]; a.out = (float*)d_out; a.ws = (unsigned char*)d_ws;
#if MK_N_LAUNCHES == 1
    (void)hipMemsetAsync(d_ws, 0, 65536, stream);
    void* args[] = {&a};
    if (PROBE_DUP >= 0) {
        a.ph_lo = 0; a.ph_hi = PROBE_DUP > 7 ? 0 : PROBE_DUP + 1;
        (void)hipLaunchCooperativeKernel((const void*)fwd_kernel, dim3(grid), dim3(NTHREADS), args, LDS_BYTES, stream);
        a.ph_lo = PROBE_DUP > 7 ? 0 : PROBE_DUP; a.ph_hi = 8; a.li = 1;
    } else { a.ph_lo = 0; a.ph_hi = 8; }
    hipError_t e = hipLaunchCooperativeKernel((const void*)fwd_kernel, dim3(grid), dim3(NTHREADS), args, LDS_BYTES, stream);
    if (e != hipSuccess) fprintf(stderr, "cooperative launch failed: %s (grid %d)\n", hipGetErrorString(e), grid);
#else
    for (int p = 0; p < 8; ++p) { a.ph_lo = p; a.ph_hi = p + 1; hipLaunchKernelGGL(fwd_kernel, dim3(grid), dim3(NTHREADS), LDS_BYTES, stream, a); }
#endif
}
```
